# Optimizing an MI355X kernel written in HIP

```python
import jax, jax.numpy as jnp
from jax import lax
import numpy as np

D_MODEL = 1024
BATCH = 2
SEQ = 8192
DEPTH = 1
DEC_BATCH = 1
DEC_SEQ = 16384
PAST_LEN = 128

D_CONV = D_MODEL // 2
D_RWKV = D_MODEL - D_CONV
CONV_WIDTH = 3
HEAD_DIM = 64
N_RWKV_HEADS = D_RWKV // HEAD_DIM
DECAY_RANK = 64
AAA_RANK = 64
GATE_RANK = 128
N_DIR = 2
D_RWKV_IN = 3 * D_RWKV + DECAY_RANK + AAA_RANK + GATE_RANK
D_IN = 3 * D_CONV + D_RWKV_IN
D_FF = 4 * D_MODEL
NORM_EPS = 1e-6
GN_EPS = 64e-5

kernel_name = 'hymba_conv_rwkv7_bidir_encoder'


def _rms_norm(x, g):
    xf = x.astype(jnp.float32)
    y = xf * lax.rsqrt(jnp.mean(xf * xf, axis=-1, keepdims=True) + NORM_EPS)
    return (y * g.astype(jnp.float32)).astype(x.dtype)


def _short_conv_mixer(z, conv_w):
    gate_b, gate_c, u = jnp.split(z, 3, axis=-1)
    cu = gate_c * u
    pad = CONV_WIDTH // 2
    conv = lax.conv_general_dilated(
        cu, conv_w[:, None, :].astype(cu.dtype), window_strides=(1,),
        padding=((pad, pad),), dimension_numbers=('NWC', 'WIO', 'NWC'),
        feature_group_count=D_CONV)
    return gate_b * conv


def _wkv7_scan(r, w, k, v, a, b):
    s0 = jnp.zeros(r.shape[1:] + (HEAD_DIM,), jnp.float32)

    def step(S, inp):
        r_t, w_t, k_t, v_t, a_t, b_t = inp
        sa = jnp.einsum('dbhvk,dbhk->dbhv', S, a_t)
        S = S * w_t[..., None, :] + sa[..., :, None] * b_t[..., None, :] + v_t[..., :, None] * k_t[..., None, :]
        return S, jnp.einsum('dbhvk,dbhk->dbhv', S, r_t)

    _, y = lax.scan(step, s0, (r, w, k, v, a, b))
    return y


def _rwkv7_bidir_mixer(z, mu_shift, w0, w_up, a0, a_up, g_up, k_k, k_a, r_k, ln_x_w, ln_x_b):
    bsz, seq, _ = z.shape
    f32 = jnp.float32
    zs = jnp.stack([z, jnp.flip(z, axis=1)])
    prev = jnp.pad(zs[:, :, :-1], ((0, 0), (0, 0), (1, 0), (0, 0)))
    zs = zs + mu_shift[:, None, None, :] * (prev - zs)
    r, k, v, wl, al, gl = jnp.split(
        zs, [D_RWKV, 2 * D_RWKV, 3 * D_RWKV, 3 * D_RWKV + DECAY_RANK,
             3 * D_RWKV + DECAY_RANK + AAA_RANK], axis=-1)
    w_log = -jax.nn.softplus(-(w0[:, None, None, :] + jnp.einsum('dbtr,drc->dbtc', jnp.tanh(wl), w_up))) - 0.5
    decay = jnp.exp(-jnp.exp(w_log.astype(f32)))
    a = jax.nn.sigmoid(a0[:, None, None, :] + jnp.einsum('dbtr,drc->dbtc', al, a_up))
    g = jnp.einsum('dbtr,drc->dbtc', jax.nn.sigmoid(gl), g_up)

    def heads(t):
        return t.reshape(N_DIR, bsz, seq, N_RWKV_HEADS, HEAD_DIM).astype(f32)

    kk = heads(k * k_k[:, None, None, :])
    kk = kk * lax.rsqrt(jnp.maximum(jnp.sum(kk * kk, axis=-1, keepdims=True), 1e-24))
    k = k * (1.0 + (a - 1.0) * k_a[:, None, None, :])
    r_h, k_h, v_h, a_h, w_h = heads(r), heads(k), heads(v), heads(a), heads(decay)

    def tmaj(t):
        return jnp.moveaxis(t, 2, 0)

    y = _wkv7_scan(tmaj(r_h), tmaj(w_h), tmaj(k_h), tmaj(v_h), tmaj(-kk), tmaj(kk * a_h))
    y = jnp.moveaxis(y, 0, 2)
    mean = jnp.mean(y, axis=-1, keepdims=True)
    var = jnp.mean(jnp.square(y - mean), axis=-1, keepdims=True)
    y = (y - mean) * lax.rsqrt(var + GN_EPS)
    hshape = (N_DIR, 1, 1, N_RWKV_HEADS, HEAD_DIM)
    y = y * ln_x_w.reshape(hshape).astype(f32) + ln_x_b.reshape(hshape).astype(f32)
    bonus = jnp.sum(r_h * k_h * r_k[:, None, None, :, :].astype(f32), axis=-1, keepdims=True) * v_h
    out = (y + bonus).reshape(N_DIR, bsz, seq, D_RWKV) * g.astype(f32)
    out = out[0] + jnp.flip(out[1], axis=1)
    return out.astype(z.dtype)


def _encoder_layer(x, c, w_ada, b_ada, g_pre_mix, g_post_mix, w_in, conv_w, mu_shift, w0, w_up,
                   a0, a_up, g_up, k_k, k_a, r_k, ln_x_w, ln_x_b, w_out, g_pre_ffn, g_post_ffn,
                   w_ffn1, w_ffn2):
    mod = jax.nn.silu(c) @ w_ada + b_ada
    sh1, sc1, gt1, sh2, sc2, gt2 = [m[:, None, :] for m in jnp.split(mod, 6, axis=-1)]
    h = _rms_norm(x, g_pre_mix) * (1.0 + sc1) + sh1
    z = h @ w_in
    y_conv = _short_conv_mixer(z[..., :3 * D_CONV], conv_w)
    y_rwkv = _rwkv7_bidir_mixer(z[..., 3 * D_CONV:], mu_shift, w0, w_up, a0, a_up, g_up,
                                k_k, k_a, r_k, ln_x_w, ln_x_b)
    mix = jnp.concatenate([y_conv, y_rwkv], axis=-1) @ w_out
    x = x + gt1 * _rms_norm(mix, g_post_mix)
    h = _rms_norm(x, g_pre_ffn) * (1.0 + sc2) + sh2
    f = jnp.square(jax.nn.relu(h @ w_ffn1)) @ w_ffn2
    return x + gt2 * _rms_norm(f, g_post_ffn)


def setup_inputs(seed: int = 0) -> dict:
    key = jax.random.key(seed)
    ks = jax.random.split(key, 26)
    f32 = jnp.float32
    L = DEPTH

    def nrm(k, shape, scale):
        return jax.random.normal(k, shape, f32) * scale

    return {
        'x_prompt': nrm(ks[0], (BATCH, SEQ, D_MODEL), 1.0),
        'x_sample': nrm(ks[1], (DEC_BATCH, DEC_SEQ, D_MODEL), 1.0),
        'c_prompt': nrm(ks[2], (BATCH, D_MODEL), 1.0),
        'c_sample': nrm(ks[3], (DEC_BATCH, D_MODEL), 1.0),
        'w_ada': nrm(ks[4], (L, D_MODEL, 6 * D_MODEL), 0.5 * D_MODEL ** -0.5),
        'b_ada': nrm(ks[5], (L, 6 * D_MODEL), 0.02),
        'g_pre_mix': 1.0 + nrm(ks[6], (L, D_MODEL), 0.02),
        'g_post_mix': 1.0 + nrm(ks[7], (L, D_MODEL), 0.02),
        'w_in': nrm(ks[8], (L, D_MODEL, D_IN), D_MODEL ** -0.5),
        'conv_w': nrm(ks[9], (L, CONV_WIDTH, D_CONV), CONV_WIDTH ** -0.5),
        'mu_shift': jax.random.uniform(ks[10], (L, N_DIR, D_RWKV_IN), f32),
        'w0': jax.random.uniform(ks[11], (L, N_DIR, D_RWKV), f32, -6.0, 1.0),
        'w_up': nrm(ks[12], (L, N_DIR, DECAY_RANK, D_RWKV), 0.5 * DECAY_RANK ** -0.5),
        'a0': nrm(ks[13], (L, N_DIR, D_RWKV), 0.1),
        'a_up': nrm(ks[14], (L, N_DIR, AAA_RANK, D_RWKV), 0.5 * AAA_RANK ** -0.5),
        'g_up': nrm(ks[15], (L, N_DIR, GATE_RANK, D_RWKV), GATE_RANK ** -0.5),
        'k_k': 0.85 + nrm(ks[16], (L, N_DIR, D_RWKV), 0.05),
        'k_a': 1.0 + nrm(ks[17], (L, N_DIR, D_RWKV), 0.05),
        'r_k': nrm(ks[18], (L, N_DIR, N_RWKV_HEADS, HEAD_DIM), 0.1),
        'ln_x_w': 1.0 + nrm(ks[19], (L, N_DIR, D_RWKV), 0.02),
        'ln_x_b': nrm(ks[20], (L, N_DIR, D_RWKV), 0.02),
        'w_out': nrm(ks[21], (L, D_MODEL, D_MODEL), D_MODEL ** -0.5),
        'g_pre_ffn': 1.0 + nrm(ks[22], (L, D_MODEL), 0.02),
        'g_post_ffn': 1.0 + nrm(ks[23], (L, D_MODEL), 0.02),
        'w_ffn1': nrm(ks[24], (L, D_MODEL, D_FF), D_MODEL ** -0.5),
        'w_ffn2': nrm(ks[25], (L, D_FF, D_MODEL), D_FF ** -0.5),
    }


def reference(x_prompt, x_sample, c_prompt, c_sample, w_ada, b_ada, g_pre_mix, g_post_mix, w_in,
              conv_w, mu_shift, w0, w_up, a0, a_up, g_up, k_k, k_a, r_k, ln_x_w, ln_x_b, w_out,
              g_pre_ffn, g_post_ffn, w_ffn1, w_ffn2):
    y_prompt = x_prompt
    y_sample = x_sample
    for l in range(DEPTH):
        layer_params = (w_ada[l], b_ada[l], g_pre_mix[l], g_post_mix[l], w_in[l], conv_w[l],
                        mu_shift[l], w0[l], w_up[l], a0[l], a_up[l], g_up[l], k_k[l], k_a[l],
                        r_k[l], ln_x_w[l], ln_x_b[l], w_out[l], g_pre_ffn[l], g_post_ffn[l],
                        w_ffn1[l], w_ffn2[l])
        y_prompt = _encoder_layer(y_prompt, c_prompt, *layer_params)
        y_sample = _encoder_layer(y_sample, c_sample, *layer_params)
    return (y_prompt, y_sample)
```

```cpp
#include <hip/hip_runtime.h>
#include <hip/hip_cooperative_groups.h>
#include <cstdio>
#include <cstdint>
namespace cg = cooperative_groups;
namespace pg8 {
#define PG8_LAS __attribute__((address_space(3)))
typedef unsigned short bf16_t;
typedef short bf16x8 __attribute__((ext_vector_type(8)));
typedef float f32x4 __attribute__((ext_vector_type(4)));
typedef unsigned u32x4 __attribute__((ext_vector_type(4)));
constexpr int BM = 256, BK = 64, HALF = 128, HTB = HALF * BK * 2  , STAGE_BYTES = 8 * HTB, NXCD = 8, WGM = 8;

__host__ __device__ __forceinline__ int lds_byte(int r, int c) { const int st = (r >> 4) * 2 + (c >> 5), rr = r & 15, cc = c & 31, ob = rr * 64 + cc * 2; return st * 1024 + (ob ^ (((ob >> 9) & 1) << 5)); }
__host__ __device__ __forceinline__ void stage_rc(int b, int& R, int& C) { const int st = b / 1024, sb = b % 1024, swz = sb ^ (((sb >> 9) & 1) << 5); R = (st >> 1) * 16 + swz / 64; C = (st & 1) * 32 + (swz % 64) / 2; }
__host__ __device__ __forceinline__ int perm32(int rho) { const int n = rho >> 4, i = rho & 15; return 8 * (i >> 2) + 4 * n + (i & 3); }

struct Unit { int pm, pn; };
struct Gemm { const bf16_t* A; const bf16_t* Bt; int M, N, K; };

struct StaticOrder {
    int nM, nN, nwg, G, c;
    __host__ __device__ void init(int M, int N, int G_, int c_) { nM = M / BM; nN = N / BM; nwg = nM * nN; G = G_; c = c_; }
    __host__ __device__ bool next(int i, Unit& u) const {
        const long L = (long)i * G + c; if (L >= nwg) return false;
        int wgid = (int)L; { const int q = nwg / NXCD, r = nwg % NXCD, xcd = wgid % NXCD, off = wgid / NXCD; wgid = (xcd < r ? xcd * (q + 1) : r * (q + 1) + (xcd - r) * q) + off; }
        const int nig = WGM * nN, gid = wgid / nig, fm = gid * WGM, gsz = (nM - fm) < WGM ? (nM - fm) : WGM;
        u.pm = fm + ((wgid % nig) % gsz); u.pn = (wgid % nig) / gsz; return true;
    }
    __device__ __forceinline__ void a_ready(const Unit&) const {}
    __device__ __forceinline__ void done(const Unit&) const {}
};
typedef __bf16 hbf2_t __attribute__((ext_vector_type(2)));
typedef float f32x2_t __attribute__((ext_vector_type(2)));
__device__ __forceinline__ unsigned cvt_pk_bf16(float lo, float hi) { const f32x2_t v = {lo, hi}; const hbf2_t b = __builtin_convertvector(v, hbf2_t); return __builtin_bit_cast(unsigned, b); }
template <class Epi, class Sched, bool ALIGN_EPI = false, bool SP2 = false>
__device__ __forceinline__ void gemm_phase(PG8_LAS unsigned char* lds, const Gemm g, const Sched& S, const Epi& E, const int tid_in) {
    int tid = tid_in; asm volatile("" : "+v"(tid)); const int wid = __builtin_amdgcn_readfirstlane(tid >> 6), lane = tid & 63, wr = wid >> 2, wc = wid & 3, fr = lane & 15, fq = lane >> 4;
    const int K = g.K, nt = K / BK;
    unsigned voffA[2], voffB[2];
#pragma unroll
    for (int i = 0; i < 2; ++i) { int R, C; stage_rc(tid * 16 + i * 8192, R, C); const int Rb = Epi::PERM ? ((R & ~31) + perm32(R & 31)) : R;
        voffA[i] = (unsigned)(R * K + C) * 2u; voffB[i] = (unsigned)(Rb * K + C) * 2u; }
    const size_t kstep = (size_t)(BK * 2);
    const size_t hstep = (size_t)HALF * K * 2;
    const size_t tstep = 2 * hstep;
    const unsigned ldsw = (unsigned)wid * 1024u;
    const int aoff = lds_byte(wr * 64 + fr, fq * 8), boff = lds_byte(wc * 32 + fr, fq * 8);
#define PG8_SA(b, h) (((b) * 2 + (h)) * HTB)
#define PG8_SB(b, h) ((4 + (b) * 2 + (h)) * HTB)
#define PG8_STAGE(bufoff, gbase, voff) do { _Pragma("unroll") for (int _i = 0; _i < 2; ++_i) \
        __builtin_amdgcn_global_load_lds((const unsigned*)((const char*)(gbase) + (voff)[_i]), (PG8_LAS unsigned*)(lds + (bufoff) + ldsw + _i * 8192), 16, 0, 0); } while (0)
#define PG8_LDA(dst, b, h) do { _Pragma("unroll") for (int m = 0; m < 4; ++m) _Pragma("unroll") for (int k = 0; k < 2; ++k) dst[m][k] = *(const PG8_LAS bf16x8*)(lds + PG8_SA(b, h) + aoff + m * 2048 + k * 1024); } while (0)
#define PG8_LDB(dst, b, h) do { _Pragma("unroll") for (int n = 0; n < 2; ++n) _Pragma("unroll") for (int k = 0; k < 2; ++k) dst[n][k] = *(const PG8_LAS bf16x8*)(lds + PG8_SB(b, h) + boff + n * 2048 + k * 1024); } while (0)
#define PG8_MMA(ai, bj, At, Bt) do { __builtin_amdgcn_s_setprio(1); _Pragma("unroll") for (int m = 0; m < 4; ++m) _Pragma("unroll") for (int n = 0; n < 2; ++n) _Pragma("unroll") for (int k = 0; k < 2; ++k) \
        acc[ai][bj][m][n] = __builtin_amdgcn_mfma_f32_16x16x32_bf16(Bt[n][k], At[m][k], acc[ai][bj][m][n], 0, 0, 0); __builtin_amdgcn_s_setprio(0); } while (0)
#define PG8_WAIT_V(n) asm volatile("s_waitcnt vmcnt(" #n ")" ::: "memory")
#define PG8_WAIT_L(n) asm volatile("s_waitcnt lgkmcnt(" #n ")" ::: "memory")
#define PG8_BAR __builtin_amdgcn_s_barrier()
#define PG8_SCHED __builtin_amdgcn_sched_barrier(0)
    Unit cur, nxt; int ui = 0;
    if (!S.next(0, cur)) return;
    f32x4 acc[2][2][4][2];
#pragma unroll
    for (int a = 0; a < 2; ++a)
#pragma unroll
        for (int b = 0; b < 2; ++b)
#pragma unroll
            for (int m = 0; m < 4; ++m)
#pragma unroll
                for (int n = 0; n < 2; ++n) acc[a][b][m][n] = (f32x4){0.f, 0.f, 0.f, 0.f};
    bf16x8 At[4][2], B0[2][2], B1[2][2];
    const char* cA = (const char*)g.A + (size_t)cur.pm * tstep; const char* cB = (const char*)g.Bt + (size_t)cur.pn * tstep;
    S.a_ready(cur);
    if constexpr (SP2) {
        PG8_STAGE(PG8_SB(0, 0), cB, voffB); PG8_STAGE(PG8_SB(0, 1), cB + hstep, voffB); PG8_STAGE(PG8_SA(0, 0), cA, voffA); PG8_STAGE(PG8_SA(0, 1), cA + hstep, voffA);
        if (wr == 1) PG8_BAR;
        PG8_WAIT_V(2); PG8_BAR;
        PG8_STAGE(PG8_SB(1, 0), cB + kstep, voffB); PG8_STAGE(PG8_SA(1, 0), cA + kstep, voffA); PG8_STAGE(PG8_SB(1, 1), cB + hstep + kstep, voffB);
        PG8_WAIT_V(6); PG8_BAR;
    } else {
        PG8_STAGE(PG8_SB(0, 0), cB, voffB); PG8_STAGE(PG8_SA(0, 0), cA, voffA); PG8_STAGE(PG8_SB(0, 1), cB + hstep, voffB); PG8_STAGE(PG8_SA(0, 1), cA + hstep, voffA);
        if (wr == 1) PG8_BAR;
        PG8_WAIT_V(4); PG8_BAR;
        PG8_STAGE(PG8_SB(1, 0), cB + kstep, voffB); PG8_STAGE(PG8_SA(1, 0), cA + kstep, voffA); PG8_STAGE(PG8_SB(1, 1), cB + hstep + kstep, voffB);
        PG8_WAIT_V(6); PG8_BAR;
    }
    for (;;) {
        const bool has_next = S.next(ui + 1, nxt);
        const char* nA = has_next ? (const char*)g.A + (size_t)nxt.pm * tstep : cA; const char* nB = has_next ? (const char*)g.Bt + (size_t)nxt.pn * tstep : cB;
        for (int t = 0; t < nt; t += 2) {
            const bool last = (t == nt - 2);
            const char* a1 = cA + (size_t)(t + 1) * kstep;
            const char* a2 = last ? nA : cA + (size_t)(t + 2) * kstep; const char* b2 = last ? nB : cB + (size_t)(t + 2) * kstep;
            const char* a3 = a2 + kstep; const char* b3 = b2 + kstep;
            if (last && has_next) S.a_ready(nxt);
            if constexpr (SP2) {
            PG8_LDB(B0, 0, 0); PG8_LDB(B1, 0, 1); PG8_SCHED; PG8_LDA(At, 0, 0); PG8_STAGE(PG8_SA(1, 1), a1 + hstep, voffA);
            PG8_WAIT_V(8); PG8_WAIT_L(0); PG8_BAR; PG8_MMA(0, 0, At, B0); PG8_MMA(0, 1, At, B1); PG8_BAR; PG8_SCHED;
            PG8_LDA(At, 0, 1); PG8_STAGE(PG8_SB(0, 0), b2, voffB); PG8_STAGE(PG8_SB(0, 1), b2 + hstep, voffB); PG8_STAGE(PG8_SA(0, 0), a2, voffA);
            PG8_WAIT_V(8); PG8_WAIT_L(0); PG8_BAR; PG8_MMA(1, 0, At, B0); PG8_MMA(1, 1, At, B1); PG8_BAR; PG8_SCHED;
            PG8_LDB(B0, 1, 0); PG8_LDB(B1, 1, 1); PG8_SCHED; PG8_LDA(At, 1, 0); PG8_STAGE(PG8_SA(0, 1), a2 + hstep, voffA);
            PG8_WAIT_V(8); PG8_WAIT_L(0); PG8_BAR; PG8_MMA(0, 0, At, B0); PG8_MMA(0, 1, At, B1); PG8_BAR; PG8_SCHED;
            PG8_LDA(At, 1, 1); PG8_STAGE(PG8_SB(1, 0), b3, voffB); PG8_STAGE(PG8_SB(1, 1), b3 + hstep, voffB); PG8_STAGE(PG8_SA(1, 0), a3, voffA);
            PG8_WAIT_V(8); PG8_WAIT_L(0); PG8_BAR; PG8_MMA(1, 0, At, B0); PG8_MMA(1, 1, At, B1); PG8_BAR; PG8_SCHED;
            } else {
            PG8_LDB(B0, 0, 0); PG8_SCHED; PG8_LDA(At, 0, 0); PG8_STAGE(PG8_SA(1, 1), a1 + hstep, voffA);
            PG8_WAIT_L(8); PG8_BAR; PG8_WAIT_L(0); PG8_MMA(0, 0, At, B0); PG8_BAR; PG8_SCHED;
            PG8_LDB(B1, 0, 1); PG8_STAGE(PG8_SB(0, 0), b2, voffB);
            PG8_BAR; PG8_WAIT_L(0); PG8_MMA(0, 1, At, B1); PG8_BAR;
            PG8_LDA(At, 0, 1); PG8_STAGE(PG8_SA(0, 0), a2, voffA);
            PG8_BAR; PG8_WAIT_L(0); PG8_MMA(1, 0, At, B0); PG8_BAR; PG8_SCHED;
            PG8_STAGE(PG8_SB(0, 1), b2 + hstep, voffB);
            PG8_WAIT_V(6); PG8_BAR; PG8_MMA(1, 1, At, B1); PG8_BAR;
            PG8_LDB(B0, 1, 0); PG8_SCHED; PG8_LDA(At, 1, 0); PG8_STAGE(PG8_SA(0, 1), a2 + hstep, voffA);
            PG8_WAIT_L(8); PG8_BAR; PG8_WAIT_L(0); PG8_MMA(0, 0, At, B0); PG8_BAR; PG8_SCHED;
            PG8_LDB(B1, 1, 1); PG8_STAGE(PG8_SB(1, 0), b3, voffB);
            PG8_BAR; PG8_WAIT_L(0); PG8_MMA(0, 1, At, B1); PG8_BAR;
            PG8_LDA(At, 1, 1); PG8_STAGE(PG8_SA(1, 0), a3, voffA);
            PG8_BAR; PG8_WAIT_L(0); PG8_MMA(1, 0, At, B0); PG8_BAR; PG8_SCHED;
            PG8_STAGE(PG8_SB(1, 1), b3 + hstep, voffB);
            PG8_WAIT_V(6); PG8_BAR; PG8_MMA(1, 1, At, B1); PG8_BAR;
            }
        }
        if constexpr (ALIGN_EPI) { if (wr == 0) PG8_BAR; }
        if constexpr (!Epi::AFTER_DRAIN) { E(acc, cur, wr, wc, fr, fq); S.done(cur); }
        if (!has_next) break;
#pragma unroll
        for (int a = 0; a < 2; ++a)
#pragma unroll
            for (int b = 0; b < 2; ++b)
#pragma unroll
                for (int m = 0; m < 4; ++m)
#pragma unroll
                    for (int n = 0; n < 2; ++n) acc[a][b][m][n] = (f32x4){0.f, 0.f, 0.f, 0.f};
        cur = nxt; cA = nA; cB = nB; ++ui;
        if constexpr (ALIGN_EPI) { if (wr == 1) PG8_BAR; }
    }
    PG8_WAIT_V(0);
    if constexpr (!ALIGN_EPI) { if (wr == 0) PG8_BAR; }
    PG8_BAR;
    if constexpr (Epi::AFTER_DRAIN) { E.fused(acc, cur, wr, wc, fr, fq, lds, wid, lane); S.done(cur); }
#undef PG8_SA
#undef PG8_SB
#undef PG8_STAGE
#undef PG8_LDA
#undef PG8_LDB
#undef PG8_MMA
#undef PG8_WAIT_V
#undef PG8_WAIT_L
#undef PG8_BAR
#undef PG8_SCHED
}
}
namespace pg8 {
struct EpiB {
    static constexpr bool PERM = true, AFTER_DRAIN = false;
    bf16_t* O0; int ld0; int split; bf16_t* O1; int ld1; int act;
    unsigned* ready; unsigned nbytes; int cu_lo;
    __device__ __forceinline__ void operator()(const f32x4 (&acc)[2][2][4][2], const Unit& u, int wr, int wc, int fr, int fq) const {
        const int row0 = u.pm * BM + wr * 64 + fr;
        if (cu_lo > 0 && u.pn >= cu_lo && u.pn < split) {
            const int colc = 512 + 128 * (u.pn - cu_lo) + wc * 32 + 8 * fq;
#pragma unroll
            for (int ai = 0; ai < 2; ++ai)
#pragma unroll
                for (int m = 0; m < 4; ++m) { const f32x4 v0 = acc[ai][0][m][0] * acc[ai][1][m][0], v1 = acc[ai][0][m][1] * acc[ai][1][m][1];
                    u32x4 w; w.x = cvt_pk_bf16(v0[0], v0[1]); w.y = cvt_pk_bf16(v0[2], v0[3]); w.z = cvt_pk_bf16(v1[0], v1[1]); w.w = cvt_pk_bf16(v1[2], v1[3]);
                    *(u32x4*)(O0 + (size_t)(row0 + ai * HALF + m * 16) * ld0 + colc) = w; }
            return; }
        bf16_t* base; int ld, colt;
        if (u.pn < split) { base = O0; ld = ld0; colt = u.pn * BM; } else { base = O1; ld = ld1; colt = (u.pn - split) * BM; }
        const int col0 = colt + wc * 32 + 8 * fq;
#pragma unroll
        for (int ai = 0; ai < 2; ++ai)
#pragma unroll
            for (int m = 0; m < 4; ++m) { bf16_t* rowp = base + (size_t)(row0 + ai * HALF + m * 16) * ld + col0;
#pragma unroll
                for (int bj = 0; bj < 2; ++bj) { f32x4 v0 = acc[ai][bj][m][0], v1 = acc[ai][bj][m][1];
                    if (act) {
#pragma unroll
                        for (int e = 0; e < 4; ++e) { float a = fmaxf(v0[e], 0.f), b = fmaxf(v1[e], 0.f); v0[e] = a * a; v1[e] = b * b; } }
                    u32x4 w; w.x = cvt_pk_bf16(v0[0], v0[1]); w.y = cvt_pk_bf16(v0[2], v0[3]); w.z = cvt_pk_bf16(v1[0], v1[1]); w.w = cvt_pk_bf16(v1[2], v1[3]);
                    if (ready) __builtin_amdgcn_raw_buffer_store_b128(w, __builtin_amdgcn_make_buffer_rsrc(O0, 0, (int)nbytes, 0x00020000), (unsigned)((size_t)((rowp + bj * HALF) - O0) * 2), 0,   16);
                    else *(u32x4*)(rowp + bj * HALF) = w; } }
        if (ready) {
            asm volatile("s_waitcnt vmcnt(0)" ::: "memory");
            if (fr == 0 && fq == 0) __hip_atomic_fetch_add(ready + 64 * u.pm, 1u, __ATOMIC_RELAXED, __HIP_MEMORY_SCOPE_AGENT); }
    }
};
struct CountedOrder : StaticOrder {
    const unsigned* ready; unsigned need; int is_wave0;
    __device__ __forceinline__ void a_ready(const Unit& u) const {
        if (is_wave0) { unsigned polls = 0;
            while ((unsigned)__builtin_amdgcn_readfirstlane(__hip_atomic_load(ready + 64 * u.pm, __ATOMIC_RELAXED, __HIP_MEMORY_SCOPE_AGENT)) < need && ++polls < (1u << 22)) __builtin_amdgcn_s_sleep(2);
            __builtin_amdgcn_fence(__ATOMIC_ACQUIRE, "agent");
            asm volatile("s_waitcnt vmcnt(0)" ::: "memory"); }
        asm volatile("" ::: "memory"); __builtin_amdgcn_s_barrier(); asm volatile("" ::: "memory");
    }
};
}
constexpr int NWAVES = 8, NTHR = 512;
constexpr int DM = 1024, MTOK = 32768, DIN = 3328, DC3 = 1536, ZCP = 1024, DR = 1792, DFF = 4096, DH = 512;
constexpr int LDS_BYTES = 163840;
constexpr float NORM_EPS = 1e-6f, GN_EPS = 64e-5f;
constexpr size_t MiB = 1u << 20;
constexpr size_t WS_MOD = 0, WS_BAR = 512 * 1024, WS_WUP = 1 * MiB, WS_AUP = WS_WUP + 131072, WS_GUP = WS_AUP + 131072;
constexpr size_t WS_WIN = 3 * MiB, WS_WO = 9 * MiB + 512 * 1024, WS_ZR = 13 * MiB, WS_ZC = 125 * MiB, WS_HS = 221 * MiB;
constexpr size_t WS_W1 = 237 * MiB, WS_W2 = 245 * MiB;
constexpr size_t WS_MIX = 32 * MiB, WS_XN2 = 96 * MiB, WS_F = 160 * MiB;
constexpr size_t WS_NEED = 253 * MiB;
constexpr size_t DO_XN = 0, DO_YCAT = 0, DO_PB = 0, DO_QB = 32 * MiB, DO_AHID = 0;

typedef unsigned short bf16;
typedef unsigned v4u __attribute__((ext_vector_type(4)));
typedef unsigned v2u __attribute__((ext_vector_type(2)));
typedef float f32x4 __attribute__((ext_vector_type(4)));
typedef short bf16x8 __attribute__((ext_vector_type(8)));
#define LAS __attribute__((address_space(3)))
#define LANEID_FRESH() ({ unsigned m_ = ~0u; asm volatile("" : "+s"(m_)); (int)__builtin_amdgcn_mbcnt_hi(m_, __builtin_amdgcn_mbcnt_lo(m_, 0u)); })
#define LDS_WAIT() asm volatile("s_waitcnt lgkmcnt(0)" ::: "memory")

__device__ __forceinline__ unsigned f2bf(float f) { unsigned u = __builtin_bit_cast(unsigned, f); return (u + 0x7fffu + ((u >> 16) & 1u)) >> 16; }
__device__ __forceinline__ unsigned pk2(float lo, float hi) { return f2bf(lo) | (f2bf(hi) << 16); }
__device__ __forceinline__ float bf2f(unsigned u) { return __builtin_bit_cast(float, u << 16); }
__device__ __forceinline__ f32x4 ld4bf(const bf16* p) { const v2u w = *(const v2u*)p; f32x4 r; r.x = bf2f(w.x & 0xffffu); r.y = __builtin_bit_cast(float, w.x & 0xffff0000u); r.z = bf2f(w.y & 0xffffu); r.w = __builtin_bit_cast(float, w.y & 0xffff0000u); return r; }
__device__ __forceinline__ float wave_sum(float v) {
#pragma unroll
    for (int o = 1; o < 64; o <<= 1) v += __shfl_xor(v, o);
    return v;
}
template <int CTRL> __device__ __forceinline__ float dpp_mov(float x) { return __builtin_bit_cast(float, __builtin_amdgcn_update_dpp(0, __builtin_bit_cast(int, x), CTRL, 0xf, 0xf, true)); }
__device__ __forceinline__ float sum16(float x) { x += dpp_mov<0xB1>(x); x += dpp_mov<0x4E>(x); x += dpp_mov<0x124>(x); x += dpp_mov<0x128>(x); return x; }
__device__ __forceinline__ float sigmoidf_(float x) { return 1.f / (1.f + __expf(-x)); }
__device__ __forceinline__ int seq_beg(int m) { return m < 8192 ? 0 : (m < 16384 ? 8192 : 16384); }
__device__ __forceinline__ int seq_end(int m) { return m < 8192 ? 8192 : (m < 16384 ? 16384 : 32768); }
__device__ __forceinline__ int seq_id(int m) { return m < 8192 ? 0 : (m < 16384 ? 1 : 2); }

struct Args { const float* in[26]; float* out; unsigned char* ws; int ph_lo, ph_hi; };
typedef const __attribute__((address_space(4))) Args* KArgs;
enum { I_XP = 0, I_XS, I_CP, I_CS, I_WADA, I_BADA, I_GPRE, I_GPOST, I_WIN, I_CONVW, I_MU, I_W0, I_WUP, I_A0, I_AUP, I_GUP, I_KK, I_KA, I_RK, I_LNW, I_LNB, I_WOUT, I_GPRE2, I_GPOST2, I_W1, I_W2 };

__device__ __forceinline__ void transpose_item(const float* W, int K, int N, bf16* WT, LAS float* scr, int item, int lane, int ldk = 0, int kdst = 0, bool convperm = false) {
    if (ldk == 0) ldk = K;
    const int nblk = N / 32, kb = item / nblk, nb = item % nblk, k0 = 64 * kb, n0 = 32 * nb;
    int dn0 = n0; if (convperm && n0 >= 512 && n0 < 1536) { const int isu = n0 >= 1024, ch = n0 - (isu ? 1024 : 512); dn0 = 512 + 256 * (ch >> 7) + 128 * isu + (ch & 127); }
    float tv[32];
#pragma unroll
    for (int i = 0; i < 32; ++i) tv[i] = W[(size_t)(k0 + 2 * i + (lane >> 5)) * N + n0 + (lane & 31)];
#pragma unroll
    for (int i = 0; i < 32; ++i) scr[(2 * i + (lane >> 5)) * 33 + (lane & 31)] = tv[i];
    LDS_WAIT();
    const int c = lane & 7;
#pragma unroll
    for (int j = 0; j < 4; ++j) { const int n = (lane >> 3) + 8 * j; const LAS float* s = scr + (8 * c) * 33 + n;
        v4u o; o.x = pk2(s[0 * 33], s[1 * 33]); o.y = pk2(s[2 * 33], s[3 * 33]); o.z = pk2(s[4 * 33], s[5 * 33]); o.w = pk2(s[6 * 33], s[7 * 33]);
        *(v4u*)(WT + (size_t)(dn0 + n) * ldk + kdst + k0 + 8 * c) = o; }
    LDS_WAIT();
}

typedef short bf16x4 __attribute__((ext_vector_type(4)));
typedef __bf16 hbf2 __attribute__((ext_vector_type(2)));
typedef float f32x2_ __attribute__((ext_vector_type(2)));
__device__ __forceinline__ unsigned cvtpk(float lo, float hi) { const f32x2_ v = {lo, hi}; const hbf2 b = __builtin_convertvector(v, hbf2); return __builtin_bit_cast(unsigned, b); }
__device__ __forceinline__ bf16x4 pk4(f32x4 v) { v2u w; w.x = cvtpk(v.x, v.y); w.y = cvtpk(v.z, v.w); return __builtin_bit_cast(bf16x4, w); }
__device__ __forceinline__ bf16x8 pk8(f32x4 a, f32x4 b) { v4u w; w.x = cvtpk(a.x, a.y); w.y = cvtpk(a.z, a.w); w.z = cvtpk(b.x, b.y); w.w = cvtpk(b.z, b.w); return __builtin_bit_cast(bf16x8, w); }
__device__ __forceinline__ bf16x8 cat8(bf16x4 a, bf16x4 b) { return __builtin_shufflevector(a, b, 0, 1, 2, 3, 4, 5, 6, 7); }
#define BPERM(src, v) __builtin_bit_cast(float, __builtin_amdgcn_ds_bpermute(((src) & 63) << 2, __builtin_bit_cast(int, (v))))
#define MFMA32(a, b, c) __builtin_amdgcn_mfma_f32_16x16x32_bf16(a, b, c, 0, 0, 0)
#define MFMA16(a, b, c) __builtin_amdgcn_mfma_f32_16x16x16bf16_1k(a, b, c, 0, 0, 0)
#ifndef DBG_NOHS
#define DBG_NOHS 0
#endif
constexpr int YP = 1536;

template <int MODE>
__device__ __forceinline__ void scan_unit(KArgs ka, LAS unsigned char* lds, const bf16* Zr_in, const bf16* WupT, const bf16* AupT, const bf16* GupT,
                                          const int d, const int wrow, bf16* PBH, bf16* QB, const bf16* HS, bf16* YC, const int wave_s) {
    constexpr bool PA = (MODE != 0), PP = (MODE == 2); constexpr int NTL = 4;
    typedef const __attribute__((address_space(1))) bf16* gbf16p;
    gbf16p Zr = (gbf16p)Zr_in; asm volatile("" : "+s"(Zr));
    int tid = wave_s * 64 + LANEID_FRESH(); asm volatile("" : "+v"(tid));
    const int lane = tid & 63, h = __builtin_amdgcn_readfirstlane(tid >> 6), n = lane & 15, g = lane >> 4;
    const int row0 = wrow * 256, sb = seq_beg(row0), se = seq_end(row0);
    const int chb = h * 64 + 4 * n;
    const size_t unit = (size_t)((d * 128 + wrow) * 8 + h) * 4096;
    const f32x4 z4 = {0.f, 0.f, 0.f, 0.f};
    constexpr int TG = PA ? 64 : 256, NG = 256 / TG, SPG = TG / 16;
    LAS bf16* Aw = (LAS bf16*)lds; LAS bf16* Aa = Aw + TG * 72; LAS bf16* Ag = Aa + TG * 72;
    LAS float* HP = (LAS float*)(lds + 20480) + h * 4096;
    const int stp = d ? -1 : 1;
    f32x4 H[4][NTL];
#pragma unroll
    for (int kc = 0; kc < 4; ++kc)
#pragma unroll
        for (int vc = 0; vc < NTL; ++vc) {
            if (PA) { H[kc][vc] = z4; f32x4 idt;
#pragma unroll
                for (int i = 0; i < 4; ++i) idt[i] = (16 * g + 4 * i + kc == 4 * n + vc) ? 1.f : 0.f;
                *(LAS f32x4*)(HP + ((kc * 4 + vc) * 64 + lane) * 4) = idt; }
            else H[kc][vc] = ld4bf(HS + unit + ((kc * 4 + vc) * 64 + lane) * 4);
        }
#pragma unroll 1
    for (int grp = 0; grp < NG; ++grp) {
        {
            int tl = wave_s * 64 + LANEID_FRESH(); asm volatile("" : "+v"(tl));
            constexpr int QPR = PA ? 32 : 64, ITS = TG * QPR / NTHR;
#pragma unroll 2
            for (int it = 0; it < ITS; ++it) { const int e = tl + NTHR * it, tok = e / QPR, col = 4 * (e % QPR), jj = grp * TG + tok;
                const int m = d ? row0 + 255 - jj : row0 + jj, mp = m - stp, zc = 1536 + col;
                const f32x4 cur = ld4bf((const bf16*)(Zr + (size_t)m * DR + zc)); f32x4 prv = z4; if (mp >= sb && mp < se) prv = ld4bf((const bf16*)(Zr + (size_t)mp * DR + zc));
                const f32x4 mu4 = *(const f32x4*)(ka->in[I_MU] + d * DR + zc); f32x4 zs = cur + mu4 * (prv - cur);
                if (col < 64) {
#pragma unroll
                    for (int q = 0; q < 4; ++q) zs[q] = 1.f - 2.f * __builtin_amdgcn_rcpf(1.f + __expf(2.f * zs[q]));
                    *(LAS v2u*)(Aw + tok * 72 + col) = __builtin_bit_cast(v2u, pk4(zs)); }
                else if (col < 128) *(LAS v2u*)(Aa + tok * 72 + col - 64) = __builtin_bit_cast(v2u, pk4(zs));
                else {
#pragma unroll
                    for (int q = 0; q < 4; ++q) zs[q] = __builtin_amdgcn_rcpf(1.f + __expf(-zs[q]));
                    *(LAS v2u*)(Ag + tok * 136 + col - 128) = __builtin_bit_cast(v2u, pk4(zs)); } }
        }
        __syncthreads();
#pragma unroll 1
        for (int sg = 0; sg < SPG; ++sg) { const int s4 = grp * SPG + sg;
            int ln = LANEID_FRESH(); asm volatile("" : "+v"(ln));
            const int n = ln & 15, g = ln >> 4, chl = h * 64 + 4 * n;
            bf16x4 idB;
#pragma unroll
            for (int j = 0; j < 4; ++j) idB[j] = (4 * g + j == n) ? (short)0x3F80 : (short)0;
            const int jj0 = 16 * s4 + 4 * g;
            const f32x4 mur = *(const f32x4*)(ka->in[I_MU] + d * DR + chl), muk = *(const f32x4*)(ka->in[I_MU] + d * DR + 512 + chl), muv = *(const f32x4*)(ka->in[I_MU] + d * DR + 1024 + chl);
            const f32x4 kkp = *(const f32x4*)(ka->in[I_KK] + d * DH + chl), kap = *(const f32x4*)(ka->in[I_KA] + d * DH + chl);
            f32x4 rkp = z4; if (!PA) rkp = *(const f32x4*)(ka->in[I_RK] + d * DH + chl);
            const f32x4 w0p = *(const f32x4*)(ka->in[I_W0] + d * DH + chl), a0p = *(const f32x4*)(ka->in[I_A0] + d * DH + chl);
            const int m0 = d ? row0 + 255 - jj0 : row0 + jj0;
            const bf16* wbase = WupT + ((size_t)((d * 8 + h) * 8) * 64 + ln) * 8; const bf16* abase = AupT + ((size_t)((d * 8 + h) * 8) * 64 + ln) * 8;
            f32x4 accw[4], acca[4];
#pragma unroll
            for (int c = 0; c < 4; ++c) { accw[c] = z4; acca[c] = z4; }
#pragma unroll
            for (int ks = 0; ks < 2; ++ks) { const bf16x8 aw = *(const LAS bf16x8*)(Aw + (16 * sg + n) * 72 + 32 * ks + 8 * g), aa = *(const LAS bf16x8*)(Aa + (16 * sg + n) * 72 + 32 * ks + 8 * g);
#pragma unroll
                for (int c = 0; c < 4; ++c) { const int wo = (c * 2 + ks) * 512;
                    accw[c] = MFMA32(aw, *(const bf16x8*)(wbase + wo), accw[c]); acca[c] = MFMA32(aa, *(const bf16x8*)(abase + wo), acca[c]); } }
            v2u zr[5], zk[5], zv[5];
#define UZ(w, c) __builtin_bit_cast(float, ((c) & 1) ? (((c) & 2) ? (w).y : (w).x) & 0xffff0000u : (((c) & 2) ? (w).y : (w).x) << 16)
#pragma unroll
            for (int q = 0; q < 5; ++q) { const int mq = m0 + (q - 1) * stp; const bool ok = (q > 0) || (mq >= sb && mq < se);
                zr[q] = (v2u){0u, 0u}; zk[q] = zr[q]; zv[q] = zr[q];
                if (ok) { gbf16p zp = Zr + (size_t)mq * DR + chl; typedef const __attribute__((address_space(1))) v2u* gv2; zr[q] = *(gv2)zp; zk[q] = *(gv2)(zp + 512); zv[q] = *(gv2)(zp + 1024); } }
            __builtin_amdgcn_sched_barrier(0);
            float ss[4] = {0.f, 0.f, 0.f, 0.f};
#pragma unroll
            for (int c = 0; c < 4; ++c)
#pragma unroll
                for (int i = 0; i < 4; ++i) { const float kq = (UZ(zk[i + 1], c) + muk[c] * (UZ(zk[i], c) - UZ(zk[i + 1], c))) * kkp[c]; ss[i] += kq * kq; }
#pragma unroll
            for (int i = 0; i < 4; ++i) ss[i] = rsqrtf(fmaxf(sum16(ss[i]), 1e-24f));
            bf16x4 Atc[4], Btc[4], Ktc[4], Vc[4], Rtc[4];
            float rk[4] = {0.f, 0.f, 0.f, 0.f}, cle[4];
#pragma unroll
            for (int c = 0; c < 4; ++c) { f32x4 At, Bt, Kt, Vv, Rt; float lw[4], E[5];
#pragma unroll
                for (int i = 0; i < 4; ++i) lw[i] = -0.60653066f * __builtin_amdgcn_rcpf(1.f + __expf(-(accw[c][i] + w0p[c])));
                {
                    const float p0 = lw[0], p1 = p0 + lw[1], p2 = p1 + lw[2], p3 = p2 + lw[3];
                    const float t1 = BPERM(ln - 16, p3); float inc = p3 + (g >= 1 ? t1 : 0.f); const float t2 = BPERM(ln - 32, inc); inc += (g >= 2 ? t2 : 0.f);
                    const float ex = inc - p3; cle[c] = BPERM(48 + n, inc);
                    E[0] = __expf(ex); E[1] = __expf(ex + p0); E[2] = __expf(ex + p1); E[3] = __expf(ex + p2); E[4] = __expf(inc); }
#pragma unroll
                for (int i = 0; i < 4; ++i) {
                    const float kx = UZ(zk[i + 1], c) + muk[c] * (UZ(zk[i], c) - UZ(zk[i + 1], c));
                    const float av = __builtin_amdgcn_rcpf(1.f + __expf(-(acca[c][i] + a0p[c])));
                    const float kn = kx * kkp[c] * ss[i], km = kx * (1.f + (av - 1.f) * kap[c]), b = kn * av;
                    const float einv = __builtin_amdgcn_rcpf(E[i + 1]);
                    At[i] = -kn * E[i]; Bt[i] = b * einv; Kt[i] = km * einv;
                    Vv[i] = UZ(zv[i + 1], c) + muv[c] * (UZ(zv[i], c) - UZ(zv[i + 1], c));
                    if (!PA) { const float r = UZ(zr[i + 1], c) + mur[c] * (UZ(zr[i], c) - UZ(zr[i + 1], c)); Rt[i] = r * E[i + 1]; rk[i] += r * km * rkp[c]; } }
                Atc[c] = pk4(At); Btc[c] = pk4(Bt); Ktc[c] = pk4(Kt); Vc[c] = pk4(Vv); if (!PA) Rtc[c] = pk4(Rt);
                }
            bf16x8 AtT[2], BtT[2], KtT[2], RtT[2];
#pragma unroll
            for (int ks = 0; ks < 2; ++ks) {
                AtT[ks] = pk8(MFMA16(Atc[2 * ks], idB, z4), MFMA16(Atc[2 * ks + 1], idB, z4));
                BtT[ks] = pk8(MFMA16(Btc[2 * ks], idB, z4), MFMA16(Btc[2 * ks + 1], idB, z4));
                KtT[ks] = pk8(MFMA16(Ktc[2 * ks], idB, z4), MFMA16(Ktc[2 * ks + 1], idB, z4));
                if (!PA) RtT[ks] = pk8(MFMA16(Rtc[2 * ks], idB, z4), MFMA16(Rtc[2 * ks + 1], idB, z4)); }
            f32x4 Nn = MFMA32(AtT[1], BtT[1], MFMA32(AtT[0], BtT[0], z4));
            f32x4 NT = MFMA32(BtT[1], AtT[1], MFMA32(BtT[0], AtT[0], z4));
            f32x4 Akt = MFMA32(KtT[1], AtT[1], MFMA32(KtT[0], AtT[0], z4));
#pragma unroll
            for (int i = 0; i < 4; ++i) { const int rr = 4 * g + i; if (!(n < rr)) Nn[i] = 0.f; if (!(rr < n)) { NT[i] = 0.f; Akt[i] = 0.f; } }
            bf16x4 pRB, pRK;
            if (!PA) { f32x4 Arbt = MFMA32(BtT[1], RtT[1], MFMA32(BtT[0], RtT[0], z4)), Arkt = MFMA32(KtT[1], RtT[1], MFMA32(KtT[0], RtT[0], z4));
#pragma unroll
                for (int i = 0; i < 4; ++i) if (!(4 * g + i <= n)) { Arbt[i] = 0.f; Arkt[i] = 0.f; }
                pRB = pk4(Arbt); pRK = pk4(Arkt); }
            const bf16x4 pN = pk4(Nn), pNT = pk4(NT), pAk = pk4(Akt);
            const f32x4 N2 = MFMA16(pNT, pN, z4), NT2 = MFMA16(pN, pNT, z4);
            const bf16x4 pN2 = pk4(N2), pNT2 = pk4(NT2);
            const f32x4 N4 = MFMA16(pNT2, pN2, z4), NT4 = MFMA16(pN2, pNT2, z4);
            const bf16x4 pN4 = pk4(N4), pNT4 = pk4(NT4);
            const bf16x4 pNT8 = pk4(MFMA16(pN4, pNT4, z4));
            __builtin_amdgcn_sched_barrier(0);
            f32x4 Y[4];
            {
                constexpr int hv = PP ? 1 : 0;
                f32x4 X[4];
#pragma unroll
                for (int v = 0; v < 4; ++v) { const int vc = v;
                    const bf16x8 Hb0 = pk8(H[0][vc], H[1][vc]), Hb1 = pk8(H[2][vc], H[3][vc]);
                    X[v] = MFMA32(AtT[1], Hb1, MFMA32(AtT[0], Hb0, z4));
                    if (hv == 0) X[v] = MFMA16(pAk, Vc[v], X[v]);
                    if (!PA) Y[v] = MFMA32(RtT[1], Hb1, MFMA32(RtT[0], Hb0, z4)); }
#pragma unroll
                for (int v = 0; v < 4; ++v) X[v] = MFMA16(pNT8, pk4(X[v]), X[v]);
#pragma unroll
                for (int v = 0; v < 4; ++v) X[v] = MFMA16(pNT4, pk4(X[v]), X[v]);
#pragma unroll
                for (int v = 0; v < 4; ++v) X[v] = MFMA16(pNT2, pk4(X[v]), X[v]);
#pragma unroll
                for (int v = 0; v < 4; ++v) X[v] = MFMA16(pNT, pk4(X[v]), X[v]);
                f32x4 g15[4];
#pragma unroll
                for (int c = 0; c < 4; ++c) g15[c] = __builtin_amdgcn_mfma_f32_16x16x4f32(g == 0 ? __expf(cle[c]) : 0.f, 1.f, z4, 0, 0, 0);
#pragma unroll
                for (int v = 0; v < 4; ++v) { const int vc = v; const bf16x4 pU = pk4(X[v]);
                    if (hv == 0) { const bf16x8 UV = cat8(pU, Vc[v]);
                        if (!PA) Y[v] = MFMA32(cat8(pRB, pRK), UV, Y[v]);
#pragma unroll
                        for (int kc = 0; kc < 4; ++kc) H[kc][vc] = MFMA32(cat8(Btc[kc], Ktc[kc]), UV, H[kc][vc]) * g15[kc]; }
                    else {
#pragma unroll
                        for (int kc = 0; kc < 4; ++kc) H[kc][vc] = MFMA16(Btc[kc], pU, H[kc][vc]) * g15[kc]; } }
                if (PA) {
#pragma unroll
                    for (int vp = 0; vp < 4; vp += 2) { f32x4 Hp[2][4], Xp[2];
#pragma unroll
                        for (int t = 0; t < 2; ++t)
#pragma unroll
                            for (int kc = 0; kc < 4; ++kc) Hp[t][kc] = *(const LAS f32x4*)(HP + ((kc * 4 + vp + t) * 64 + ln) * 4);
#pragma unroll
                        for (int t = 0; t < 2; ++t) Xp[t] = MFMA32(AtT[1], pk8(Hp[t][2], Hp[t][3]), MFMA32(AtT[0], pk8(Hp[t][0], Hp[t][1]), z4));
#pragma unroll
                        for (int t = 0; t < 2; ++t) Xp[t] = MFMA16(pNT8, pk4(Xp[t]), Xp[t]);
#pragma unroll
                        for (int t = 0; t < 2; ++t) Xp[t] = MFMA16(pNT4, pk4(Xp[t]), Xp[t]);
#pragma unroll
                        for (int t = 0; t < 2; ++t) Xp[t] = MFMA16(pNT2, pk4(Xp[t]), Xp[t]);
#pragma unroll
                        for (int t = 0; t < 2; ++t) Xp[t] = MFMA16(pNT, pk4(Xp[t]), Xp[t]);
#pragma unroll
                        for (int t = 0; t < 2; ++t) { const bf16x4 pU = pk4(Xp[t]);
#pragma unroll
                            for (int kc = 0; kc < 4; ++kc) *(LAS f32x4*)(HP + ((kc * 4 + vp + t) * 64 + ln) * 4) = MFMA16(Btc[kc], pU, Hp[t][kc]) * g15[kc]; } }
                }
            }
            __builtin_amdgcn_sched_barrier(0);
            if (!PA) {
                int le = LANEID_FRESH(); asm volatile("" : "+v"(le));
                const int ne = le & 15, ge = le >> 4, che = h * 64 + 4 * ne;
                {   const f32x4 lnw = *(const f32x4*)(ka->in[I_LNW] + d * DH + che), lnb = *(const f32x4*)(ka->in[I_LNB] + d * DH + che);
#pragma unroll
                    for (int i = 0; i < 4; ++i) { const float mean = sum16((Y[0][i] + Y[1][i]) + (Y[2][i] + Y[3][i])) * (1.f / 64.f);
                        float q = 0.f;
#pragma unroll
                        for (int v = 0; v < 4; ++v) { const float dv = Y[v][i] - mean; q += dv * dv; }
                        const float rs = rsqrtf(sum16(q) * (1.f / 64.f) + GN_EPS), rki = sum16(rk[i]);
#pragma unroll
                        for (int v = 0; v < 4; ++v) Y[v][i] = (Y[v][i] - mean) * rs * lnw[v] + lnb[v] + rki * bf2f((unsigned short)Vc[v][i]); } }
                __builtin_amdgcn_sched_barrier(0);
                f32x4 accg[4]; const bf16* gbase = GupT + ((size_t)((d * 8 + h) * 16) * 64 + le) * 8;
#pragma unroll
                for (int c = 0; c < 4; ++c) accg[c] = z4;
#pragma unroll
                for (int ks = 0; ks < 4; ++ks) { const bf16x8 ag = *(const LAS bf16x8*)(Ag + (16 * sg + ne) * 136 + 32 * ks + 8 * ge);
#pragma unroll
                    for (int c = 0; c < 4; ++c) accg[c] = MFMA32(ag, *(const bf16x8*)(gbase + (c * 4 + ks) * 512), accg[c]); }
#pragma unroll
                for (int i = 0; i < 4; ++i) { f32x4 o;
#pragma unroll
                    for (int v = 0; v < 4; ++v) o[v] = Y[v][i] * accg[v][i];
                    *(v2u*)(YC + (size_t)((d ? row0 + 255 - 16 * s4 - 4 * ge : row0 + 16 * s4 + 4 * ge) + i * stp) * YP + 512 + d * 512 + che) = __builtin_bit_cast(v2u, pk4(o)); }
            }
        }
        __syncthreads();
    }
    if (PA) {
#pragma unroll
        for (int kc = 0; kc < 4; ++kc) {
#pragma unroll
            for (int vc = 0; vc < 4; ++vc) *(v2u*)(QB + unit + ((kc * 4 + vc) * 64 + lane) * 4) = __builtin_bit_cast(v2u, pk4(H[kc][vc]));
#pragma unroll
            for (int ks = 0; ks < 2; ++ks) { f32x4 e0, e1;
#pragma unroll
                for (int jj = 0; jj < 4; ++jj) { const int src = 16 * (n >> 2) + 4 * g + jj;
                    e0[jj] = HP[((kc * 4 + 2 * ks) * 64 + src) * 4 + (n & 3)]; e1[jj] = HP[((kc * 4 + 2 * ks + 1) * 64 + src) * 4 + (n & 3)]; }
                *(bf16x8*)(PBH + unit + ((kc * 2 + ks) * 64 + lane) * 8) = pk8(e0, e1); } }
    }
}
constexpr int REPT = 1, REP0 = 1, REP3 = 1, REP4 = 1, REP5 = 1, REPG = 1, REP1 = 1, REPC = 1, REP7 = 1, REP12 = 1;
__global__ void __launch_bounds__(NTHR, 2) fwd(Args args) {
    extern __shared__ __attribute__((aligned(16))) unsigned char lds_raw[];
    LAS unsigned char* lds = (LAS unsigned char*)lds_raw;
    int bar_epoch = 0;
    const int wave_s = __builtin_amdgcn_readfirstlane(threadIdx.x >> 6);
    const int G = gridDim.x, bx = blockIdx.x;
    const int vcu = (G % 8 == 0) ? (bx % 8) * (G / 8) + bx / 8 : bx;
    const int NGW = G * NWAVES;
#define MKTID() (wave_s * 64 + LANEID_FRESH())
#define PHASE_IDS int tid = MKTID(); asm volatile("" : "+v"(tid)); const int lane = tid & 63, wave = __builtin_amdgcn_readfirstlane(tid >> 6), gw = vcu * NWAVES + wave; (void)gw; (void)lane;
#define PHASE_PTRS KArgs ka = (KArgs)__builtin_amdgcn_kernarg_segment_ptr(); asm volatile("" : "+s"(ka)); unsigned char* ws = ka->ws; unsigned char* dob = (unsigned char*)ka->out; \
    const float* xp = ka->in[I_XP]; const float* xs = ka->in[I_XS]; \
    float* MOD = (float*)(ws + WS_MOD); \
    bf16* WupT = (bf16*)(ws + WS_WUP); bf16* AupT = (bf16*)(ws + WS_AUP); bf16* GupT = (bf16*)(ws + WS_GUP); \
    bf16* HSB = (bf16*)(ws + WS_HS); bf16* PBH = (bf16*)(dob + DO_PB); bf16* QB = (bf16*)(dob + DO_QB); \
    bf16* WinT = (bf16*)(ws + WS_WIN); bf16* WoT = (bf16*)(ws + WS_WO); bf16* W1T = (bf16*)(ws + WS_W1); bf16* W2T = (bf16*)(ws + WS_W2); \
    bf16* Zr = (bf16*)(ws + WS_ZR); bf16* Zc = (bf16*)(ws + WS_ZC); \
    bf16* MIX = (bf16*)(ws + WS_MIX); bf16* XN2 = (bf16*)(ws + WS_XN2); bf16* FB = (bf16*)(ws + WS_F); \
    bf16* XN = (bf16*)(dob + DO_XN); bf16* YCAT = (bf16*)(dob + DO_YCAT); bf16* AHID = (bf16*)(dob + DO_AHID);
    const int lo = args.ph_lo, hi = args.ph_hi;
#define IN(k) (lo <= (k) && (k) < hi)
#define SEAM(k) do { if (IN(k) && IN((k) + 1)) { if ((k) == 0) cg::this_grid().sync(); else { \
        asm volatile("s_waitcnt vmcnt(0)" ::: "memory"); __syncthreads(); \
        if (MKTID() == 0) { unsigned* bw_ = (unsigned*)((KArgs)__builtin_amdgcn_kernarg_segment_ptr())->ws + WS_BAR / 4; \
            __builtin_amdgcn_fence(__ATOMIC_RELEASE, "agent"); asm volatile("s_waitcnt vmcnt(0)" ::: "memory"); \
            const unsigned e_ = (unsigned)(++bar_epoch), ng_ = (G % 8 == 0) ? 8u : 1u;                      \
            const unsigned old_ = __hip_atomic_fetch_add(bw_ + 64 * (ng_ == 8u ? (bx & 7) : 0), 1u, __ATOMIC_RELAXED, __HIP_MEMORY_SCOPE_AGENT); \
            if (old_ + 1u == e_ * ((unsigned)G / ng_)) { const unsigned t_ = __hip_atomic_fetch_add(bw_ + 64 * 8, 1u, __ATOMIC_RELAXED, __HIP_MEMORY_SCOPE_AGENT); \
                if (t_ + 1u == e_ * ng_) { for (unsigned q_ = 0; q_ < 8; ++q_) __hip_atomic_store(bw_ + 64 * (16 + q_), e_, __ATOMIC_RELAXED, __HIP_MEMORY_SCOPE_AGENT); } }     \
            unsigned* rel_ = bw_ + 64 * (16 + (ng_ == 8u ? (bx & 7) : 0)); unsigned sp_ = 0; \
            while (__hip_atomic_load(rel_, __ATOMIC_RELAXED, __HIP_MEMORY_SCOPE_AGENT) < e_ && ++sp_ < (1u << 24)) __builtin_amdgcn_s_sleep(1); \
            __builtin_amdgcn_fence(__ATOMIC_ACQUIRE, "agent"); asm volatile("s_waitcnt vmcnt(0)" ::: "memory"); } \
        __syncthreads(); } } } while (0)
#define XROW(m) ((m) < 16384 ? xp + (size_t)(m) * DM : xs + (size_t)((m) - 16384) * DM)

    for (int rep0 = 0; rep0 < REP0; ++rep0)
    if (IN(0)) { PHASE_PTRS PHASE_IDS
        if (bx == 0 && tid < 64) { for (int i = tid; i < 128; i += 64) __hip_atomic_store((unsigned*)(ws + WS_BAR) + 64 * i, 0u, __ATOMIC_RELAXED, __HIP_MEMORY_SCOPE_AGENT); }
        if (bx < 96) {
            LAS float* sc = (LAS float*)lds;
            for (int i = tid; i < 3072; i += NTHR) { const int s = i >> 10, k = i & 1023; const float c = (s < 2) ? ka->in[I_CP][s * 1024 + k] : ka->in[I_CS][k]; sc[i] = c / (1.f + __expf(-c)); }
            __syncthreads();
            const int col = bx * 64 + lane, k0 = wave * 128; const float* wa = ka->in[I_WADA];
            float a0 = 0.f, a1 = 0.f, a2 = 0.f;
#pragma unroll 32
            for (int k = k0; k < k0 + 128; ++k) { const float w = wa[(size_t)k * 6144 + col]; a0 += sc[k] * w; a1 += sc[1024 + k] * w; a2 += sc[2048 + k] * w; }
            LAS float* red = sc + 3072;
            red[(wave * 3 + 0) * 64 + lane] = a0; red[(wave * 3 + 1) * 64 + lane] = a1; red[(wave * 3 + 2) * 64 + lane] = a2;
            __syncthreads();
            if (tid < 192) { const int s = tid >> 6, l = tid & 63; float v = ka->in[I_BADA][bx * 64 + l];
#pragma unroll
                for (int w = 0; w < 8; ++w) v += red[(w * 3 + s) * 64 + l];
                MOD[s * 6144 + bx * 64 + l] = v; }
            __syncthreads();
        }
        LAS float* scr = (LAS float*)(lds + wave * 16384);
        constexpr int I_IN = 16 * (DIN / 32), I_O = 16 * 32, I_L = 16, I_G = 32;
        constexpr int NIT = I_IN + I_O;
        for (int it = gw; it < NIT; it += NGW) {
            int r = it;
            if (r < I_IN) { transpose_item(ka->in[I_WIN], DM, DIN, WinT, scr, r, lane, 0, 0, true); continue; } r -= I_IN;
            if (r < I_O) { transpose_item(ka->in[I_WOUT], DM, DM, WoT, scr, r, lane, YP, 0); if (r >= I_O / 2) transpose_item(ka->in[I_WOUT], DM, DM, WoT, scr, r, lane, YP, 512); continue; } r -= I_O;
            continue;
        }
        for (int q = gw * 64 + lane; q < 32768; q += NGW * 64) {
            const float* W; bf16* F; int KS, qq = q;
            if (qq < 8192) { W = ka->in[I_WUP]; F = WupT; KS = 2; } else if (qq < 16384) { qq -= 8192; W = ka->in[I_AUP]; F = AupT; KS = 2; } else { qq -= 16384; W = ka->in[I_GUP]; F = GupT; KS = 4; }
            const int ln = qq & 63, ks = (qq >> 6) % KS, rest = (qq >> 6) / KS, c = rest & 3, h = (rest >> 2) & 7, d = rest >> 5, n = ln & 15, g = ln >> 4;
            const float* src = W + ((size_t)d * (32 * KS) + 32 * ks + 8 * g) * DH + 64 * h + 4 * n + c;
            v4u o; o.x = pk2(src[0], src[DH]); o.y = pk2(src[2 * DH], src[3 * DH]); o.z = pk2(src[4 * DH], src[5 * DH]); o.w = pk2(src[6 * DH], src[7 * DH]);
            *(v4u*)(F + (size_t)qq * 8) = o;
        }
    }
    SEAM(0);

    if (IN(1)) { PHASE_PTRS PHASE_IDS
        for (int rep = 0; rep < REP1; ++rep)
        for (int rg = gw; rg < MTOK / 16; rg += NGW) {
            const int m0 = rg * 16; const float* modS = MOD + seq_id(m0) * 6144;
            f32x4 A[4], B[4];
#pragma unroll
            for (int j = 0; j < 4; ++j) { const int c = 4 * lane + 256 * j; const f32x4 g = *(const f32x4*)(ka->in[I_GPRE] + c), scv = *(const f32x4*)(modS + 1024 + c); A[j] = g * (1.f + scv); B[j] = *(const f32x4*)(modS + c); }
            for (int r = 0; r < 16; ++r) { const int m = m0 + r; const f32x4* xr = (const f32x4*)XROW(m) + lane;
                f32x4 v[4]; float ss = 0.f;
#pragma unroll
                for (int j = 0; j < 4; ++j) { v[j] = xr[64 * j]; ss += (v[j].x * v[j].x + v[j].y * v[j].y) + (v[j].z * v[j].z + v[j].w * v[j].w); }
                const float rstd = rsqrtf(wave_sum(ss) * (1.f / DM) + NORM_EPS);
                v2u* o = (v2u*)(XN + (size_t)m * DM) + lane;
#pragma unroll
                for (int j = 0; j < 4; ++j) { const f32x4 h = v[j] * rstd * A[j] + B[j]; v2u w; w.x = pk2(h.x, h.y); w.y = pk2(h.z, h.w); o[64 * j] = w; }
            }
        }
    }
    SEAM(1);

    if (IN(2)) { PHASE_PTRS
        pg8::Gemm g{XN, WinT, MTOK, DIN, DM}; pg8::StaticOrder S; S.init(MTOK, DIN, G, bx);
        pg8::EpiB E{Zc, ZCP, 6, Zr, DR, 0, nullptr, 0u, 2};
        for (int rep = 0; rep < REPG; ++rep) pg8::gemm_phase<pg8::EpiB, pg8::StaticOrder, true, true>(lds, g, S, E, MKTID());
    }
    SEAM(2);

    if (IN(3)) { PHASE_PTRS
        for (int rep = 0; rep < REP3; ++rep)
        for (int u = bx; u < 256; u += G) scan_unit<1>(ka, lds, Zr, WupT, AupT, GupT, u >> 7, u & 127, PBH, QB, nullptr, nullptr, wave_s);
    }
    SEAM(3);

    if (IN(4)) { PHASE_PTRS PHASE_IDS
        if (wave != 0) {
            LAS float* scr = (LAS float*)(lds + wave * 16384);
            constexpr int I_1 = 16 * (DFF / 32), I_2 = (DFF / 64) * 32;
            for (int rept = 0; rept < REPT; ++rept)
            for (int it = vcu * 7 + (wave - 1); it < I_1 + I_2; it += G * 7) {
                if (it < I_1) transpose_item(ka->in[I_W1], DM, DFF, W1T, scr, it, lane); else transpose_item(ka->in[I_W2], DFF, DM, W2T, scr, it - I_1, lane);
            }
        }
        for (int rep = 0; rep < REP4; ++rep)
        if (bx < 192 && wave == 0) {
            const int vc = bx & 3, h = (bx >> 2) & 7, ds = bx >> 5, d = ds & 1, s = ds >> 1;
            const int wb = (s == 0) ? 0 : (s == 1 ? 32 : 64), nwin = (s < 2) ? 32 : 64, nst = nwin - 1;
            f32x4 Hc[4]; bf16x8 Pr[3][4][2]; f32x4 Qr[3][4];
#pragma unroll
            for (int kc = 0; kc < 4; ++kc) Hc[kc] = (f32x4){0.f, 0.f, 0.f, 0.f};
#define PB_UNIT(w) ((size_t)((d * 128 + (d ? wb + nwin - 1 - (w) : wb + (w))) * 8 + h) * 4096)
#define PB_LOAD(slot, w) do { const size_t un_ = PB_UNIT(w); _Pragma("unroll") for (int kc = 0; kc < 4; ++kc) { Qr[slot][kc] = ld4bf(QB + un_ + ((kc * 4 + vc) * 64 + lane) * 4); \
        _Pragma("unroll") for (int ks = 0; ks < 2; ++ks) Pr[slot][kc][ks] = *(const bf16x8*)(PBH + un_ + ((kc * 2 + ks) * 64 + lane) * 8); } } while (0)
#define PB_STEP(slot, w) do { const size_t un_ = PB_UNIT(w); \
        _Pragma("unroll") for (int kc = 0; kc < 4; ++kc) *(v2u*)(HSB + un_ + ((kc * 4 + vc) * 64 + lane) * 4) = __builtin_bit_cast(v2u, pk4(Hc[kc])); \
        bf16x8 Hh[2], Hl[2]; \
        _Pragma("unroll") for (int ks = 0; ks < 2; ++ks) { Hh[ks] = pk8(Hc[2 * ks], Hc[2 * ks + 1]); f32x4 r0, r1; \
            _Pragma("unroll") for (int i = 0; i < 4; ++i) { r0[i] = Hc[2 * ks][i] - bf2f((unsigned short)Hh[ks][i]); r1[i] = Hc[2 * ks + 1][i] - bf2f((unsigned short)Hh[ks][4 + i]); } \
            Hl[ks] = pk8(r0, r1); } \
        _Pragma("unroll") for (int kc = 0; kc < 4; ++kc) { f32x4 acc = Qr[slot][kc]; \
            _Pragma("unroll") for (int ks = 0; ks < 2; ++ks) { acc = MFMA32(Pr[slot][kc][ks], Hh[ks], acc); acc = MFMA32(Pr[slot][kc][ks], Hl[ks], acc); } \
            Hc[kc] = acc; } \
        if ((w) + 3 < nst) PB_LOAD(slot, (w) + 3); } while (0)
            PB_LOAD(0, 0); PB_LOAD(1, 1); PB_LOAD(2, 2);
#pragma unroll 1
            for (int w = 0; w < nst; w += 3) {
                PB_STEP(0, w);
                if (w + 1 < nst) PB_STEP(1, w + 1);
                if (w + 2 < nst) PB_STEP(2, w + 2);
            }
            { const size_t un_ = PB_UNIT(nst);
#pragma unroll
              for (int kc = 0; kc < 4; ++kc) *(v2u*)(HSB + un_ + ((kc * 4 + vc) * 64 + lane) * 4) = __builtin_bit_cast(v2u, pk4(Hc[kc])); }
#undef PB_UNIT
#undef PB_LOAD
#undef PB_STEP
        }
    }
    SEAM(4);

    if (IN(5)) { PHASE_PTRS
        for (int rep = 0; rep < REP5; ++rep)
        for (int u = bx; u < 256; u += G) scan_unit<0>(ka, lds, Zr, WupT, AupT, GupT, u >> 7, u & 127, nullptr, nullptr, HSB, YCAT, wave_s);
        PHASE_IDS
        for (int rep = 0; rep < REPC; ++rep)
        for (int rg = vcu * 4 + (tid >> 7); rg < MTOK / 16; rg += G * 4) {
            const int m0 = rg * 16, sb = seq_beg(m0), se = seq_end(m0), c = 4 * (tid & 127);
            const float* cw = ka->in[I_CONVW]; const f32x4 cw0 = *(const f32x4*)(cw + c), cw1 = *(const f32x4*)(cw + 512 + c), cw2 = *(const f32x4*)(cw + 1024 + c);
            f32x4 p = {0.f, 0.f, 0.f, 0.f}, q;
            if (m0 - 1 >= sb) p = ld4bf(Zc + (size_t)(m0 - 1) * ZCP + 512 + c);
            q = ld4bf(Zc + (size_t)m0 * ZCP + 512 + c);
#pragma unroll 4
            for (int i = 0; i < 16; ++i) { const int m = m0 + i; f32x4 nx = {0.f, 0.f, 0.f, 0.f};
                if (m + 1 < se) nx = ld4bf(Zc + (size_t)(m + 1) * ZCP + 512 + c);
                const f32x4 y = ld4bf(Zc + (size_t)m * ZCP + c) * (cw0 * p + cw1 * q + cw2 * nx);
                v2u w; w.x = pk2(y.x, y.y); w.y = pk2(y.z, y.w); *(v2u*)(YCAT + (size_t)m * YP + c) = w; p = q; q = nx; }
        }
    }
    SEAM(5);

    if (IN(6)) { PHASE_PTRS
        pg8::Gemm g{YCAT, WoT, MTOK, DM, YP}; pg8::StaticOrder S; S.init(MTOK, DM, G, bx);
        pg8::EpiB E{MIX, DM, 1 << 20, nullptr, 0, 0};
        for (int rep = 0; rep < REPG; ++rep) pg8::gemm_phase<pg8::EpiB, pg8::StaticOrder, true, true>(lds, g, S, E, MKTID());
    }
    SEAM(6);

    if (IN(7)) { PHASE_PTRS PHASE_IDS
        for (int rep = 0; rep < REP7; ++rep)
        for (int rg = gw; rg < MTOK / 16; rg += NGW) {
            const int m0 = rg * 16; const float* modS = MOD + seq_id(m0) * 6144;
            f32x4 G1[4], A2[4], B2[4];
#pragma unroll
            for (int j = 0; j < 4; ++j) { const int c = 4 * lane + 256 * j;
                G1[j] = *(const f32x4*)(modS + 2048 + c) * *(const f32x4*)(ka->in[I_GPOST] + c);
                A2[j] = *(const f32x4*)(ka->in[I_GPRE2] + c) * (1.f + *(const f32x4*)(modS + 4096 + c)); B2[j] = *(const f32x4*)(modS + 3072 + c); }
            for (int r = 0; r < 16; ++r) { const int m = m0 + r; const f32x4* xr = (const f32x4*)XROW(m) + lane;
                f32x4 x[4], mx[4]; float ss = 0.f;
#pragma unroll
                for (int j = 0; j < 4; ++j) { x[j] = xr[64 * j]; mx[j] = ld4bf(MIX + (size_t)m * DM + 4 * lane + 256 * j); ss += (mx[j].x * mx[j].x + mx[j].y * mx[j].y) + (mx[j].z * mx[j].z + mx[j].w * mx[j].w); }
                const float rs1 = rsqrtf(wave_sum(ss) * (1.f / DM) + NORM_EPS); float s2 = 0.f;
#pragma unroll
                for (int j = 0; j < 4; ++j) { x[j] = x[j] + G1[j] * mx[j] * rs1; s2 += (x[j].x * x[j].x + x[j].y * x[j].y) + (x[j].z * x[j].z + x[j].w * x[j].w); }
                const float rs2 = rsqrtf(wave_sum(s2) * (1.f / DM) + NORM_EPS);
                v2u* o = (v2u*)(XN2 + (size_t)m * DM) + lane; v2u* o1 = (v2u*)(MIX + (size_t)m * DM) + lane;
#pragma unroll
                for (int j = 0; j < 4; ++j) { const f32x4 hh = x[j] * rs2 * A2[j] + B2[j]; v2u w; w.x = pk2(hh.x, hh.y); w.y = pk2(hh.z, hh.w); o[64 * j] = w;
                    v2u w1; w1.x = pk2(x[j].x, x[j].y); w1.y = pk2(x[j].z, x[j].w); o1[64 * j] = w1; }
            }
        }
    }
    SEAM(7);

#pragma unroll 1
    for (int half = 0; half < 2; ++half) {
        if (IN(8 + 2 * half)) { PHASE_PTRS
            pg8::Gemm g{XN2 + (size_t)half * 16384 * DM, W1T, 16384, DFF, DM}; pg8::StaticOrder S; S.init(16384, DFF, G, bx);
            pg8::EpiB E{AHID, DFF, 1 << 20, nullptr, 0, 1, (unsigned*)(ws + WS_BAR) + 64 * 32, (unsigned)(16384u * DFF * 2u)};
            for (int rep = 0; rep < REPG; ++rep) pg8::gemm_phase<pg8::EpiB, pg8::StaticOrder, true, true>(lds, g, S, E, MKTID());
        }
        if (IN(9 + 2 * half)) { PHASE_PTRS
            pg8::Gemm g{AHID, W2T, 16384, DM, DFF}; pg8::CountedOrder S; S.init(16384, DM, G, bx);
            S.ready = (const unsigned*)(ws + WS_BAR) + 64 * 32; S.need = 128u * (unsigned)(half + 1); S.is_wave0 = (wave_s == 0);
            pg8::EpiB E{FB + (size_t)half * 16384 * DM, DM, 1 << 20, nullptr, 0, 0};
            for (int rep = 0; rep < REPG; ++rep) pg8::gemm_phase<pg8::EpiB, pg8::CountedOrder, false, true>(lds, g, S, E, MKTID());
        }
        SEAM(9 + 2 * half);
    }

    if (IN(12)) { PHASE_PTRS PHASE_IDS
        for (int rep = 0; rep < REP12; ++rep)
        for (int rg = gw; rg < MTOK / 16; rg += NGW) {
            const int m0 = rg * 16; const float* modS = MOD + seq_id(m0) * 6144;
            f32x4 G2[4];
#pragma unroll
            for (int j = 0; j < 4; ++j) { const int c = 4 * lane + 256 * j; G2[j] = *(const f32x4*)(modS + 5120 + c) * *(const f32x4*)(ka->in[I_GPOST2] + c); }
            for (int r = 0; r < 16; ++r) { const int m = m0 + r;
                f32x4 x1[4], fx[4]; float sf = 0.f;
#pragma unroll
                for (int j = 0; j < 4; ++j) { x1[j] = ld4bf(MIX + (size_t)m * DM + 4 * lane + 256 * j); fx[j] = ld4bf(FB + (size_t)m * DM + 4 * lane + 256 * j);
                    sf += (fx[j].x * fx[j].x + fx[j].y * fx[j].y) + (fx[j].z * fx[j].z + fx[j].w * fx[j].w); }
                const float rs3 = rsqrtf(wave_sum(sf) * (1.f / DM) + NORM_EPS);
                f32x4* o = (f32x4*)(ka->out + (size_t)m * DM) + lane;
#pragma unroll
                for (int j = 0; j < 4; ++j) o[64 * j] = x1[j] + G2[j] * fx[j] * rs3;
            }
        }
    }
#undef IN
#undef SEAM
#undef XROW
}

constexpr int N_PHASES = 13;
extern "C" void kernel_launch(void* const* d_in, const int* in_sizes, int n_in, void* d_out, int out_size, void* d_ws, size_t ws_size, hipStream_t stream) {
    static int grid = 0;
    if (grid == 0) {
        if (n_in != 26 || out_size != MTOK * DM || ws_size < WS_NEED) { fprintf(stderr, "kernel_launch: unexpected shapes (n_in %d out %d ws %zu)\n", n_in, out_size, ws_size); grid = -1; return; }
        int dev = 0, cus = 0, per_cu = 0;
        hipGetDevice(&dev); hipDeviceGetAttribute(&cus, hipDeviceAttributeMultiprocessorCount, dev);
        if (hipFuncSetAttribute((const void*)fwd, hipFuncAttributeMaxDynamicSharedMemorySize, LDS_BYTES) != hipSuccess) { fprintf(stderr, "kernel_launch: hipFuncSetAttribute failed\n"); grid = -1; return; }
        if (hipOccupancyMaxActiveBlocksPerMultiprocessor(&per_cu, (const void*)fwd, NTHR, LDS_BYTES) != hipSuccess || per_cu < 1) { fprintf(stderr, "kernel_launch: occupancy query failed (%d)\n", per_cu); per_cu = 1; }
        (void)hipGetLastError();
        grid = cus * per_cu; if (grid > 256) grid = 256;
        fprintf(stderr, "kernel_launch: grid %d (cus %d per_cu %d)\n", grid, cus, per_cu);
    }
    if (grid < 0) return;
    Args a{};
    for (int i = 0; i < 26; ++i) a.in[i] = (const float*)d_in[i];
    a.out = (float*)d_out; a.ws = (unsigned char*)d_ws; a.ph_lo = 0; a.ph_hi = N_PHASES;
    void* kargs[] = {&a};
    hipError_t e = hipLaunchCooperativeKernel((const void*)fwd, dim3(grid), dim3(NTHR), kargs, LDS_BYTES, stream);
    if (e != hipSuccess) fprintf(stderr, "kernel_launch: cooperative launch failed: %s (grid %d)\n", hipGetErrorString(e), grid);
}
```

```cpp
#include <hip/hip_runtime.h>
#include <hip/hip_cooperative_groups.h>
#include <cstdio>
#include <cstdint>
namespace cg = cooperative_groups;
namespace pg8 {
#define PG8_LAS __attribute__((address_space(3)))
typedef unsigned short bf16_t;
typedef short bf16x8 __attribute__((ext_vector_type(8)));
typedef float f32x4 __attribute__((ext_vector_type(4)));
typedef unsigned u32x4 __attribute__((ext_vector_type(4)));
constexpr int BM = 256, BK = 64, HALF = 128, HTB = HALF * BK * 2  , STAGE_BYTES = 8 * HTB, NXCD = 8, WGM = 8;

__host__ __device__ __forceinline__ int lds_byte(int r, int c) { const int st = (r >> 4) * 2 + (c >> 5), rr = r & 15, cc = c & 31, ob = rr * 64 + cc * 2; return st * 1024 + (ob ^ (((ob >> 9) & 1) << 5)); }
__host__ __device__ __forceinline__ void stage_rc(int b, int& R, int& C) { const int st = b / 1024, sb = b % 1024, swz = sb ^ (((sb >> 9) & 1) << 5); R = (st >> 1) * 16 + swz / 64; C = (st & 1) * 32 + (swz % 64) / 2; }
__host__ __device__ __forceinline__ int perm32(int rho) { const int n = rho >> 4, i = rho & 15; return 8 * (i >> 2) + 4 * n + (i & 3); }

struct Unit { int pm, pn; };
struct Gemm { const bf16_t* A; const bf16_t* Bt; int M, N, K; };

struct StaticOrder {
    int nM, nN, nwg, G, c;
    __host__ __device__ void init(int M, int N, int G_, int c_) { nM = M / BM; nN = N / BM; nwg = nM * nN; G = G_; c = c_; }
    __host__ __device__ bool next(int i, Unit& u) const {
        const long L = (long)i * G + c; if (L >= nwg) return false;
        int wgid = (int)L; { const int q = nwg / NXCD, r = nwg % NXCD, xcd = wgid % NXCD, off = wgid / NXCD; wgid = (xcd < r ? xcd * (q + 1) : r * (q + 1) + (xcd - r) * q) + off; }
        const int nig = WGM * nN, gid = wgid / nig, fm = gid * WGM, gsz = (nM - fm) < WGM ? (nM - fm) : WGM;
        u.pm = fm + ((wgid % nig) % gsz); u.pn = (wgid % nig) / gsz; return true;
    }
    __device__ __forceinline__ void a_ready(const Unit&) const {}
    __device__ __forceinline__ void done(const Unit&) const {}
};
typedef __bf16 hbf2_t __attribute__((ext_vector_type(2)));
typedef float f32x2_t __attribute__((ext_vector_type(2)));
__device__ __forceinline__ unsigned cvt_pk_bf16(float lo, float hi) { const f32x2_t v = {lo, hi}; const hbf2_t b = __builtin_convertvector(v, hbf2_t); return __builtin_bit_cast(unsigned, b); }
template <class Epi, class Sched, bool ALIGN_EPI = false, bool SP2 = false>
__device__ __forceinline__ void gemm_phase(PG8_LAS unsigned char* lds, const Gemm g, const Sched& S, const Epi& E, const int tid_in) {
    int tid = tid_in; asm volatile("" : "+v"(tid)); const int wid = __builtin_amdgcn_readfirstlane(tid >> 6), lane = tid & 63, wr = wid >> 2, wc = wid & 3, fr = lane & 15, fq = lane >> 4;
    const int K = g.K, nt = K / BK;
    unsigned voffA[2], voffB[2];
#pragma unroll
    for (int i = 0; i < 2; ++i) { int R, C; stage_rc(tid * 16 + i * 8192, R, C); const int Rb = Epi::PERM ? ((R & ~31) + perm32(R & 31)) : R;
        voffA[i] = (unsigned)(R * K + C) * 2u; voffB[i] = (unsigned)(Rb * K + C) * 2u; }
    const size_t kstep = (size_t)(BK * 2);
    const size_t hstep = (size_t)HALF * K * 2;
    const size_t tstep = 2 * hstep;
    const unsigned ldsw = (unsigned)wid * 1024u;
    const int aoff = lds_byte(wr * 64 + fr, fq * 8), boff = lds_byte(wc * 32 + fr, fq * 8);
#define PG8_SA(b, h) (((b) * 2 + (h)) * HTB)
#define PG8_SB(b, h) ((4 + (b) * 2 + (h)) * HTB)
#define PG8_STAGE(bufoff, gbase, voff) do { _Pragma("unroll") for (int _i = 0; _i < 2; ++_i) \
        __builtin_amdgcn_global_load_lds((const unsigned*)((const char*)(gbase) + (voff)[_i]), (PG8_LAS unsigned*)(lds + (bufoff) + ldsw + _i * 8192), 16, 0, 0); } while (0)
#define PG8_LDA(dst, b, h) do { _Pragma("unroll") for (int m = 0; m < 4; ++m) _Pragma("unroll") for (int k = 0; k < 2; ++k) dst[m][k] = *(const PG8_LAS bf16x8*)(lds + PG8_SA(b, h) + aoff + m * 2048 + k * 1024); } while (0)
#define PG8_LDB(dst, b, h) do { _Pragma("unroll") for (int n = 0; n < 2; ++n) _Pragma("unroll") for (int k = 0; k < 2; ++k) dst[n][k] = *(const PG8_LAS bf16x8*)(lds + PG8_SB(b, h) + boff + n * 2048 + k * 1024); } while (0)
#define PG8_MMA(ai, bj, At, Bt) do { __builtin_amdgcn_s_setprio(1); _Pragma("unroll") for (int m = 0; m < 4; ++m) _Pragma("unroll") for (int n = 0; n < 2; ++n) _Pragma("unroll") for (int k = 0; k < 2; ++k) \
        acc[ai][bj][m][n] = __builtin_amdgcn_mfma_f32_16x16x32_bf16(Bt[n][k], At[m][k], acc[ai][bj][m][n], 0, 0, 0); __builtin_amdgcn_s_setprio(0); } while (0)
#define PG8_WAIT_V(n) asm volatile("s_waitcnt vmcnt(" #n ")" ::: "memory")
#define PG8_WAIT_L(n) asm volatile("s_waitcnt lgkmcnt(" #n ")" ::: "memory")
#define PG8_BAR __builtin_amdgcn_s_barrier()
#define PG8_SCHED __builtin_amdgcn_sched_barrier(0)
    Unit cur, nxt; int ui = 0;
    if (!S.next(0, cur)) return;
    f32x4 acc[2][2][4][2];
#pragma unroll
    for (int a = 0; a < 2; ++a)
#pragma unroll
        for (int b = 0; b < 2; ++b)
#pragma unroll
            for (int m = 0; m < 4; ++m)
#pragma unroll
                for (int n = 0; n < 2; ++n) acc[a][b][m][n] = (f32x4){0.f, 0.f, 0.f, 0.f};
    bf16x8 At[4][2], B0[2][2], B1[2][2];
    const char* cA = (const char*)g.A + (size_t)cur.pm * tstep; const char* cB = (const char*)g.Bt + (size_t)cur.pn * tstep;
    S.a_ready(cur);
    if constexpr (SP2) {
        PG8_STAGE(PG8_SB(0, 0), cB, voffB); PG8_STAGE(PG8_SB(0, 1), cB + hstep, voffB); PG8_STAGE(PG8_SA(0, 0), cA, voffA); PG8_STAGE(PG8_SA(0, 1), cA + hstep, voffA);
        if (wr == 1) PG8_BAR;
        PG8_WAIT_V(2); PG8_BAR;
        PG8_STAGE(PG8_SB(1, 0), cB + kstep, voffB); PG8_STAGE(PG8_SA(1, 0), cA + kstep, voffA); PG8_STAGE(PG8_SB(1, 1), cB + hstep + kstep, voffB);
        PG8_WAIT_V(6); PG8_BAR;
    } else {
        PG8_STAGE(PG8_SB(0, 0), cB, voffB); PG8_STAGE(PG8_SA(0, 0), cA, voffA); PG8_STAGE(PG8_SB(0, 1), cB + hstep, voffB); PG8_STAGE(PG8_SA(0, 1), cA + hstep, voffA);
        if (wr == 1) PG8_BAR;
        PG8_WAIT_V(4); PG8_BAR;
        PG8_STAGE(PG8_SB(1, 0), cB + kstep, voffB); PG8_STAGE(PG8_SA(1, 0), cA + kstep, voffA); PG8_STAGE(PG8_SB(1, 1), cB + hstep + kstep, voffB);
        PG8_WAIT_V(6); PG8_BAR;
    }
    for (;;) {
        const bool has_next = S.next(ui + 1, nxt);
        const char* nA = has_next ? (const char*)g.A + (size_t)nxt.pm * tstep : cA; const char* nB = has_next ? (const char*)g.Bt + (size_t)nxt.pn * tstep : cB;
        for (int t = 0; t < nt; t += 2) {
            const bool last = (t == nt - 2);
            const char* a1 = cA + (size_t)(t + 1) * kstep;
            const char* a2 = last ? nA : cA + (size_t)(t + 2) * kstep; const char* b2 = last ? nB : cB + (size_t)(t + 2) * kstep;
            const char* a3 = a2 + kstep; const char* b3 = b2 + kstep;
            if (last && has_next) S.a_ready(nxt);
            if constexpr (SP2) {
            PG8_LDB(B0, 0, 0); PG8_LDB(B1, 0, 1); PG8_SCHED; PG8_LDA(At, 0, 0); PG8_STAGE(PG8_SA(1, 1), a1 + hstep, voffA);
            PG8_WAIT_V(8); PG8_WAIT_L(0); PG8_BAR; PG8_MMA(0, 0, At, B0); PG8_MMA(0, 1, At, B1); PG8_BAR; PG8_SCHED;
            PG8_LDA(At, 0, 1); PG8_STAGE(PG8_SB(0, 0), b2, voffB); PG8_STAGE(PG8_SB(0, 1), b2 + hstep, voffB); PG8_STAGE(PG8_SA(0, 0), a2, voffA);
            PG8_WAIT_V(8); PG8_WAIT_L(0); PG8_BAR; PG8_MMA(1, 0, At, B0); PG8_MMA(1, 1, At, B1); PG8_BAR; PG8_SCHED;
            PG8_LDB(B0, 1, 0); PG8_LDB(B1, 1, 1); PG8_SCHED; PG8_LDA(At, 1, 0); PG8_STAGE(PG8_SA(0, 1), a2 + hstep, voffA);
            PG8_WAIT_V(8); PG8_WAIT_L(0); PG8_BAR; PG8_MMA(0, 0, At, B0); PG8_MMA(0, 1, At, B1); PG8_BAR; PG8_SCHED;
            PG8_LDA(At, 1, 1); PG8_STAGE(PG8_SB(1, 0), b3, voffB); PG8_STAGE(PG8_SB(1, 1), b3 + hstep, voffB); PG8_STAGE(PG8_SA(1, 0), a3, voffA);
            PG8_WAIT_V(8); PG8_WAIT_L(0); PG8_BAR; PG8_MMA(1, 0, At, B0); PG8_MMA(1, 1, At, B1); PG8_BAR; PG8_SCHED;
            } else {
            PG8_LDB(B0, 0, 0); PG8_SCHED; PG8_LDA(At, 0, 0); PG8_STAGE(PG8_SA(1, 1), a1 + hstep, voffA);
            PG8_WAIT_L(8); PG8_BAR; PG8_WAIT_L(0); PG8_MMA(0, 0, At, B0); PG8_BAR; PG8_SCHED;
            PG8_LDB(B1, 0, 1); PG8_STAGE(PG8_SB(0, 0), b2, voffB);
            PG8_BAR; PG8_WAIT_L(0); PG8_MMA(0, 1, At, B1); PG8_BAR;
            PG8_LDA(At, 0, 1); PG8_STAGE(PG8_SA(0, 0), a2, voffA);
            PG8_BAR; PG8_WAIT_L(0); PG8_MMA(1, 0, At, B0); PG8_BAR; PG8_SCHED;
            PG8_STAGE(PG8_SB(0, 1), b2 + hstep, voffB);
            PG8_WAIT_V(6); PG8_BAR; PG8_MMA(1, 1, At, B1); PG8_BAR;
            PG8_LDB(B0, 1, 0); PG8_SCHED; PG8_LDA(At, 1, 0); PG8_STAGE(PG8_SA(0, 1), a2 + hstep, voffA);
            PG8_WAIT_L(8); PG8_BAR; PG8_WAIT_L(0); PG8_MMA(0, 0, At, B0); PG8_BAR; PG8_SCHED;
            PG8_LDB(B1, 1, 1); PG8_STAGE(PG8_SB(1, 0), b3, voffB);
            PG8_BAR; PG8_WAIT_L(0); PG8_MMA(0, 1, At, B1); PG8_BAR;
            PG8_LDA(At, 1, 1); PG8_STAGE(PG8_SA(1, 0), a3, voffA);
            PG8_BAR; PG8_WAIT_L(0); PG8_MMA(1, 0, At, B0); PG8_BAR; PG8_SCHED;
            PG8_STAGE(PG8_SB(1, 1), b3 + hstep, voffB);
            PG8_WAIT_V(6); PG8_BAR; PG8_MMA(1, 1, At, B1); PG8_BAR;
            }
        }
        if constexpr (ALIGN_EPI) { if (wr == 0) PG8_BAR; }
        if constexpr (!Epi::AFTER_DRAIN) { E(acc, cur, wr, wc, fr, fq); S.done(cur); }
        if (!has_next) break;
#pragma unroll
        for (int a = 0; a < 2; ++a)
#pragma unroll
            for (int b = 0; b < 2; ++b)
#pragma unroll
                for (int m = 0; m < 4; ++m)
#pragma unroll
                    for (int n = 0; n < 2; ++n) acc[a][b][m][n] = (f32x4){0.f, 0.f, 0.f, 0.f};
        cur = nxt; cA = nA; cB = nB; ++ui;
        if constexpr (ALIGN_EPI) { if (wr == 1) PG8_BAR; }
    }
    PG8_WAIT_V(0);
    if constexpr (!ALIGN_EPI) { if (wr == 0) PG8_BAR; }
    PG8_BAR;
    if constexpr (Epi::AFTER_DRAIN) { E.fused(acc, cur, wr, wc, fr, fq, lds, wid, lane); S.done(cur); }
#undef PG8_SA
#undef PG8_SB
#undef PG8_STAGE
#undef PG8_LDA
#undef PG8_LDB
#undef PG8_MMA
#undef PG8_WAIT_V
#undef PG8_WAIT_L
#undef PG8_BAR
#undef PG8_SCHED
}
}
namespace pg8 {
struct EpiB {
    static constexpr bool PERM = true, AFTER_DRAIN = false;
    bf16_t* O0; int ld0; int split; bf16_t* O1; int ld1; int act;
    unsigned* ready; unsigned nbytes; int cu_lo;
    __device__ __forceinline__ void operator()(const f32x4 (&acc)[2][2][4][2], const Unit& u, int wr, int wc, int fr, int fq) const {
        const int row0 = u.pm * BM + wr * 64 + fr;
        if (cu_lo > 0 && u.pn >= cu_lo && u.pn < split) {
            const int colc = 512 + 128 * (u.pn - cu_lo) + wc * 32 + 8 * fq;
#pragma unroll
            for (int ai = 0; ai < 2; ++ai)
#pragma unroll
                for (int m = 0; m < 4; ++m) { const f32x4 v0 = acc[ai][0][m][0] * acc[ai][1][m][0], v1 = acc[ai][0][m][1] * acc[ai][1][m][1];
                    u32x4 w; w.x = cvt_pk_bf16(v0[0], v0[1]); w.y = cvt_pk_bf16(v0[2], v0[3]); w.z = cvt_pk_bf16(v1[0], v1[1]); w.w = cvt_pk_bf16(v1[2], v1[3]);
                    *(u32x4*)(O0 + (size_t)(row0 + ai * HALF + m * 16) * ld0 + colc) = w; }
            return; }
        bf16_t* base; int ld, colt;
        if (u.pn < split) { base = O0; ld = ld0; colt = u.pn * BM; } else { base = O1; ld = ld1; colt = (u.pn - split) * BM; }
        const int col0 = colt + wc * 32 + 8 * fq;
#pragma unroll
        for (int ai = 0; ai < 2; ++ai)
#pragma unroll
            for (int m = 0; m < 4; ++m) { bf16_t* rowp = base + (size_t)(row0 + ai * HALF + m * 16) * ld + col0;
#pragma unroll
                for (int bj = 0; bj < 2; ++bj) { f32x4 v0 = acc[ai][bj][m][0], v1 = acc[ai][bj][m][1];
                    if (act) {
#pragma unroll
                        for (int e = 0; e < 4; ++e) { float a = fmaxf(v0[e], 0.f), b = fmaxf(v1[e], 0.f); v0[e] = a * a; v1[e] = b * b; } }
                    u32x4 w; w.x = cvt_pk_bf16(v0[0], v0[1]); w.y = cvt_pk_bf16(v0[2], v0[3]); w.z = cvt_pk_bf16(v1[0], v1[1]); w.w = cvt_pk_bf16(v1[2], v1[3]);
                    if (ready) __builtin_amdgcn_raw_buffer_store_b128(w, __builtin_amdgcn_make_buffer_rsrc(O0, 0, (int)nbytes, 0x00020000), (unsigned)((size_t)((rowp + bj * HALF) - O0) * 2), 0,   16);
                    else *(u32x4*)(rowp + bj * HALF) = w; } }
        if (ready) {
            asm volatile("s_waitcnt vmcnt(0)" ::: "memory");
            if (fr == 0 && fq == 0) __hip_atomic_fetch_add(ready + 64 * u.pm, 1u, __ATOMIC_RELAXED, __HIP_MEMORY_SCOPE_AGENT); }
    }
};
struct CountedOrder : StaticOrder {
    const unsigned* ready; unsigned need; int is_wave0;
    __device__ __forceinline__ void a_ready(const Unit& u) const {
        if (is_wave0) { unsigned polls = 0;
            while ((unsigned)__builtin_amdgcn_readfirstlane(__hip_atomic_load(ready + 64 * u.pm, __ATOMIC_RELAXED, __HIP_MEMORY_SCOPE_AGENT)) < need && ++polls < (1u << 22)) __builtin_amdgcn_s_sleep(2);
            __builtin_amdgcn_fence(__ATOMIC_ACQUIRE, "agent");
            asm volatile("s_waitcnt vmcnt(0)" ::: "memory"); }
        asm volatile("" ::: "memory"); __builtin_amdgcn_s_barrier(); asm volatile("" ::: "memory");
    }
};
}
constexpr int NWAVES = 8, NTHR = 512;
constexpr int DM = 1024, MTOK = 32768, DIN = 3328, DC3 = 1536, ZCP = 1024, DR = 1792, DFF = 4096, DH = 512;
constexpr int LDS_BYTES = 163840;
constexpr float NORM_EPS = 1e-6f, GN_EPS = 64e-5f;
constexpr size_t MiB = 1u << 20;
constexpr size_t WS_MOD = 0, WS_BAR = 512 * 1024, WS_WUP = 1 * MiB, WS_AUP = WS_WUP + 131072, WS_GUP = WS_AUP + 131072;
constexpr size_t WS_WIN = 3 * MiB, WS_WO = 9 * MiB + 512 * 1024, WS_ZR = 13 * MiB, WS_ZC = 125 * MiB, WS_HS = 221 * MiB;
constexpr size_t WS_W1 = 13 * MiB, WS_W2 = 21 * MiB, WS_MIX = 32 * MiB, WS_XN2 = 96 * MiB, WS_F = 160 * MiB;
constexpr size_t WS_NEED = 253 * MiB;
constexpr size_t DO_XN = 0, DO_YCAT = 0, DO_PB = 0, DO_QB = 32 * MiB, DO_AHID = 0;

typedef unsigned short bf16;
typedef unsigned v4u __attribute__((ext_vector_type(4)));
typedef unsigned v2u __attribute__((ext_vector_type(2)));
typedef float f32x4 __attribute__((ext_vector_type(4)));
typedef short bf16x8 __attribute__((ext_vector_type(8)));
#define LAS __attribute__((address_space(3)))
#define LANEID_FRESH() ({ unsigned m_ = ~0u; asm volatile("" : "+s"(m_)); (int)__builtin_amdgcn_mbcnt_hi(m_, __builtin_amdgcn_mbcnt_lo(m_, 0u)); })
#define LDS_WAIT() asm volatile("s_waitcnt lgkmcnt(0)" ::: "memory")

__device__ __forceinline__ unsigned f2bf(float f) { unsigned u = __builtin_bit_cast(unsigned, f); return (u + 0x7fffu + ((u >> 16) & 1u)) >> 16; }
__device__ __forceinline__ unsigned pk2(float lo, float hi) { return f2bf(lo) | (f2bf(hi) << 16); }
__device__ __forceinline__ float bf2f(unsigned u) { return __builtin_bit_cast(float, u << 16); }
__device__ __forceinline__ f32x4 ld4bf(const bf16* p) { const v2u w = *(const v2u*)p; f32x4 r; r.x = bf2f(w.x & 0xffffu); r.y = __builtin_bit_cast(float, w.x & 0xffff0000u); r.z = bf2f(w.y & 0xffffu); r.w = __builtin_bit_cast(float, w.y & 0xffff0000u); return r; }
__device__ __forceinline__ f32x4 ld4bf_nt(const bf16* p) { const v2u w = __builtin_nontemporal_load((const v2u*)p); f32x4 r; r.x = bf2f(w.x & 0xffffu); r.y = __builtin_bit_cast(float, w.x & 0xffff0000u); r.z = bf2f(w.y & 0xffffu); r.w = __builtin_bit_cast(float, w.y & 0xffff0000u); return r; }
__device__ __forceinline__ float wave_sum(float v) {
#pragma unroll
    for (int o = 1; o < 64; o <<= 1) v += __shfl_xor(v, o);
    return v;
}
template <int CTRL> __device__ __forceinline__ float dpp_mov(float x) { return __builtin_bit_cast(float, __builtin_amdgcn_update_dpp(0, __builtin_bit_cast(int, x), CTRL, 0xf, 0xf, true)); }
__device__ __forceinline__ float sum16(float x) { x += dpp_mov<0xB1>(x); x += dpp_mov<0x4E>(x); x += dpp_mov<0x124>(x); x += dpp_mov<0x128>(x); return x; }
__device__ __forceinline__ float sigmoidf_(float x) { return 1.f / (1.f + __expf(-x)); }
__device__ __forceinline__ int seq_beg(int m) { return m < 8192 ? 0 : (m < 16384 ? 8192 : 16384); }
__device__ __forceinline__ int seq_end(int m) { return m < 8192 ? 8192 : (m < 16384 ? 16384 : 32768); }
__device__ __forceinline__ int seq_id(int m) { return m < 8192 ? 0 : (m < 16384 ? 1 : 2); }

struct Args { const float* in[26]; float* out; unsigned char* ws; int ph_lo, ph_hi; };
typedef const __attribute__((address_space(4))) Args* KArgs;
enum { I_XP = 0, I_XS, I_CP, I_CS, I_WADA, I_BADA, I_GPRE, I_GPOST, I_WIN, I_CONVW, I_MU, I_W0, I_WUP, I_A0, I_AUP, I_GUP, I_KK, I_KA, I_RK, I_LNW, I_LNB, I_WOUT, I_GPRE2, I_GPOST2, I_W1, I_W2 };

__device__ __forceinline__ void transpose_item(const float* W, int K, int N, bf16* WT, LAS float* scr, int item, int lane, int ldk = 0, int kdst = 0, bool convperm = false) {
    if (ldk == 0) ldk = K;
    const int nblk = N / 32, kb = item / nblk, nb = item % nblk, k0 = 64 * kb, n0 = 32 * nb;
    int dn0 = n0; if (convperm && n0 >= 512 && n0 < 1536) { const int isu = n0 >= 1024, ch = n0 - (isu ? 1024 : 512); dn0 = 512 + 256 * (ch >> 7) + 128 * isu + (ch & 127); }
    float tv[32];
#pragma unroll
    for (int i = 0; i < 32; ++i) tv[i] = W[(size_t)(k0 + 2 * i + (lane >> 5)) * N + n0 + (lane & 31)];
#pragma unroll
    for (int i = 0; i < 32; ++i) scr[(2 * i + (lane >> 5)) * 33 + (lane & 31)] = tv[i];
    LDS_WAIT();
    const int c = lane & 7;
#pragma unroll
    for (int j = 0; j < 4; ++j) { const int n = (lane >> 3) + 8 * j; const LAS float* s = scr + (8 * c) * 33 + n;
        v4u o; o.x = pk2(s[0 * 33], s[1 * 33]); o.y = pk2(s[2 * 33], s[3 * 33]); o.z = pk2(s[4 * 33], s[5 * 33]); o.w = pk2(s[6 * 33], s[7 * 33]);
        *(v4u*)(WT + (size_t)(dn0 + n) * ldk + kdst + k0 + 8 * c) = o; }
    LDS_WAIT();
}

typedef short bf16x4 __attribute__((ext_vector_type(4)));
typedef __bf16 hbf2 __attribute__((ext_vector_type(2)));
typedef float f32x2_ __attribute__((ext_vector_type(2)));
__device__ __forceinline__ unsigned cvtpk(float lo, float hi) { const f32x2_ v = {lo, hi}; const hbf2 b = __builtin_convertvector(v, hbf2); return __builtin_bit_cast(unsigned, b); }
__device__ __forceinline__ bf16x4 pk4(f32x4 v) { v2u w; w.x = cvtpk(v.x, v.y); w.y = cvtpk(v.z, v.w); return __builtin_bit_cast(bf16x4, w); }
__device__ __forceinline__ bf16x8 pk8(f32x4 a, f32x4 b) { v4u w; w.x = cvtpk(a.x, a.y); w.y = cvtpk(a.z, a.w); w.z = cvtpk(b.x, b.y); w.w = cvtpk(b.z, b.w); return __builtin_bit_cast(bf16x8, w); }
__device__ __forceinline__ bf16x8 cat8(bf16x4 a, bf16x4 b) { return __builtin_shufflevector(a, b, 0, 1, 2, 3, 4, 5, 6, 7); }
#define BPERM(src, v) __builtin_bit_cast(float, __builtin_amdgcn_ds_bpermute(((src) & 63) << 2, __builtin_bit_cast(int, (v))))
#define MFMA32(a, b, c) __builtin_amdgcn_mfma_f32_16x16x32_bf16(a, b, c, 0, 0, 0)
#define MFMA16(a, b, c) __builtin_amdgcn_mfma_f32_16x16x16bf16_1k(a, b, c, 0, 0, 0)
#ifndef DBG_NOHS
#define DBG_NOHS 0
#endif
constexpr int YP = 1536;

template <int MODE>
__device__ __forceinline__ void scan_unit(KArgs ka, LAS unsigned char* lds, const bf16* Zr_in, const bf16* WupT, const bf16* AupT, const bf16* GupT,
                                          const int d, const int wrow, bf16* PBH, bf16* QB, const bf16* HS, bf16* YC, const int wave_s) {
    constexpr bool PA = (MODE != 0), PP = (MODE == 2); constexpr int NTL = 4;
    typedef const __attribute__((address_space(1))) bf16* gbf16p;
    gbf16p Zr = (gbf16p)Zr_in; asm volatile("" : "+s"(Zr));
    int tid = wave_s * 64 + LANEID_FRESH(); asm volatile("" : "+v"(tid));
    const int lane = tid & 63, h = __builtin_amdgcn_readfirstlane(tid >> 6), n = lane & 15, g = lane >> 4;
    const int row0 = wrow * 256, sb = seq_beg(row0), se = seq_end(row0);
    const int chb = h * 64 + 4 * n;
    const size_t unit = (size_t)((d * 128 + wrow) * 8 + h) * 4096;
    const f32x4 z4 = {0.f, 0.f, 0.f, 0.f};
    constexpr int TG = PA ? 64 : 256, NG = 256 / TG, SPG = TG / 16;
    LAS bf16* Aw = (LAS bf16*)lds; LAS bf16* Aa = Aw + TG * 72; LAS bf16* Ag = Aa + TG * 72;
    LAS float* HP = (LAS float*)(lds + 20480) + h * 4096;
    const int stp = d ? -1 : 1;
    f32x4 H[4][NTL];
#pragma unroll
    for (int kc = 0; kc < 4; ++kc)
#pragma unroll
        for (int vc = 0; vc < NTL; ++vc) {
            if (PA) { H[kc][vc] = z4; f32x4 idt;
#pragma unroll
                for (int i = 0; i < 4; ++i) idt[i] = (16 * g + 4 * i + kc == 4 * n + vc) ? 1.f : 0.f;
                *(LAS f32x4*)(HP + ((kc * 4 + vc) * 64 + lane) * 4) = idt; }
            else H[kc][vc] = ld4bf(HS + unit + ((kc * 4 + vc) * 64 + lane) * 4);
        }
#pragma unroll 1
    for (int grp = 0; grp < NG; ++grp) {
        {
            int tl = wave_s * 64 + LANEID_FRESH(); asm volatile("" : "+v"(tl));
            constexpr int QPR = PA ? 32 : 64, ITS = TG * QPR / NTHR;
#pragma unroll 2
            for (int it = 0; it < ITS; ++it) { const int e = tl + NTHR * it, tok = e / QPR, col = 4 * (e % QPR), jj = grp * TG + tok;
                const int m = d ? row0 + 255 - jj : row0 + jj, mp = m - stp, zc = 1536 + col;
                const f32x4 cur = ld4bf((const bf16*)(Zr + (size_t)m * DR + zc)); f32x4 prv = z4; if (mp >= sb && mp < se) prv = ld4bf((const bf16*)(Zr + (size_t)mp * DR + zc));
                const f32x4 mu4 = *(const f32x4*)(ka->in[I_MU] + d * DR + zc); f32x4 zs = cur + mu4 * (prv - cur);
                if (col < 64) {
#pragma unroll
                    for (int q = 0; q < 4; ++q) zs[q] = 1.f - 2.f * __builtin_amdgcn_rcpf(1.f + __expf(2.f * zs[q]));
                    *(LAS v2u*)(Aw + tok * 72 + col) = __builtin_bit_cast(v2u, pk4(zs)); }
                else if (col < 128) *(LAS v2u*)(Aa + tok * 72 + col - 64) = __builtin_bit_cast(v2u, pk4(zs));
                else {
#pragma unroll
                    for (int q = 0; q < 4; ++q) zs[q] = __builtin_amdgcn_rcpf(1.f + __expf(-zs[q]));
                    *(LAS v2u*)(Ag + tok * 136 + col - 128) = __builtin_bit_cast(v2u, pk4(zs)); } }
        }
        __syncthreads();
#pragma unroll 1
        for (int sg = 0; sg < SPG; ++sg) { const int s4 = grp * SPG + sg;
            int ln = LANEID_FRESH(); asm volatile("" : "+v"(ln));
            const int n = ln & 15, g = ln >> 4, chl = h * 64 + 4 * n;
            bf16x4 idB;
#pragma unroll
            for (int j = 0; j < 4; ++j) idB[j] = (4 * g + j == n) ? (short)0x3F80 : (short)0;
            const int jj0 = 16 * s4 + 4 * g;
            const f32x4 mur = *(const f32x4*)(ka->in[I_MU] + d * DR + chl), muk = *(const f32x4*)(ka->in[I_MU] + d * DR + 512 + chl), muv = *(const f32x4*)(ka->in[I_MU] + d * DR + 1024 + chl);
            const f32x4 kkp = *(const f32x4*)(ka->in[I_KK] + d * DH + chl), kap = *(const f32x4*)(ka->in[I_KA] + d * DH + chl);
            f32x4 rkp = z4; if (!PA) rkp = *(const f32x4*)(ka->in[I_RK] + d * DH + chl);
            const f32x4 w0p = *(const f32x4*)(ka->in[I_W0] + d * DH + chl), a0p = *(const f32x4*)(ka->in[I_A0] + d * DH + chl);
            const int m0 = d ? row0 + 255 - jj0 : row0 + jj0;
            const bf16* wbase = WupT + ((size_t)((d * 8 + h) * 8) * 64 + ln) * 8; const bf16* abase = AupT + ((size_t)((d * 8 + h) * 8) * 64 + ln) * 8;
            f32x4 accw[4], acca[4];
#pragma unroll
            for (int c = 0; c < 4; ++c) { accw[c] = z4; acca[c] = z4; }
#pragma unroll
            for (int ks = 0; ks < 2; ++ks) { const bf16x8 aw = *(const LAS bf16x8*)(Aw + (16 * sg + n) * 72 + 32 * ks + 8 * g), aa = *(const LAS bf16x8*)(Aa + (16 * sg + n) * 72 + 32 * ks + 8 * g);
#pragma unroll
                for (int c = 0; c < 4; ++c) { const int wo = (c * 2 + ks) * 512;
                    accw[c] = MFMA32(aw, *(const bf16x8*)(wbase + wo), accw[c]); acca[c] = MFMA32(aa, *(const bf16x8*)(abase + wo), acca[c]); } }
            v2u zr[5], zk[5], zv[5];
#define UZ(w, c) __builtin_bit_cast(float, ((c) & 1) ? (((c) & 2) ? (w).y : (w).x) & 0xffff0000u : (((c) & 2) ? (w).y : (w).x) << 16)
#pragma unroll
            for (int q = 0; q < 5; ++q) { const int mq = m0 + (q - 1) * stp; const bool ok = (q > 0) || (mq >= sb && mq < se);
                zr[q] = (v2u){0u, 0u}; zk[q] = zr[q]; zv[q] = zr[q];
                if (ok) { gbf16p zp = Zr + (size_t)mq * DR + chl; typedef const __attribute__((address_space(1))) v2u* gv2; zr[q] = *(gv2)zp; zk[q] = *(gv2)(zp + 512); zv[q] = *(gv2)(zp + 1024); } }
            __builtin_amdgcn_sched_barrier(0);
            float ss[4] = {0.f, 0.f, 0.f, 0.f};
#pragma unroll
            for (int c = 0; c < 4; ++c)
#pragma unroll
                for (int i = 0; i < 4; ++i) { const float kq = (UZ(zk[i + 1], c) + muk[c] * (UZ(zk[i], c) - UZ(zk[i + 1], c))) * kkp[c]; ss[i] += kq * kq; }
#pragma unroll
            for (int i = 0; i < 4; ++i) ss[i] = rsqrtf(fmaxf(sum16(ss[i]), 1e-24f));
            bf16x4 Atc[4], Btc[4], Ktc[4], Vc[4], Rtc[4];
            float rk[4] = {0.f, 0.f, 0.f, 0.f}, cle[4];
#pragma unroll
            for (int c = 0; c < 4; ++c) { f32x4 At, Bt, Kt, Vv, Rt; float lw[4], E[5];
#pragma unroll
                for (int i = 0; i < 4; ++i) lw[i] = -0.60653066f * __builtin_amdgcn_rcpf(1.f + __expf(-(accw[c][i] + w0p[c])));
                {
                    const float p0 = lw[0], p1 = p0 + lw[1], p2 = p1 + lw[2], p3 = p2 + lw[3];
                    const float t1 = BPERM(ln - 16, p3); float inc = p3 + (g >= 1 ? t1 : 0.f); const float t2 = BPERM(ln - 32, inc); inc += (g >= 2 ? t2 : 0.f);
                    const float ex = inc - p3; cle[c] = BPERM(48 + n, inc);
                    E[0] = __expf(ex); E[1] = __expf(ex + p0); E[2] = __expf(ex + p1); E[3] = __expf(ex + p2); E[4] = __expf(inc); }
#pragma unroll
                for (int i = 0; i < 4; ++i) {
                    const float kx = UZ(zk[i + 1], c) + muk[c] * (UZ(zk[i], c) - UZ(zk[i + 1], c));
                    const float av = __builtin_amdgcn_rcpf(1.f + __expf(-(acca[c][i] + a0p[c])));
                    const float kn = kx * kkp[c] * ss[i], km = kx * (1.f + (av - 1.f) * kap[c]), b = kn * av;
                    const float einv = __builtin_amdgcn_rcpf(E[i + 1]);
                    At[i] = -kn * E[i]; Bt[i] = b * einv; Kt[i] = km * einv;
                    Vv[i] = UZ(zv[i + 1], c) + muv[c] * (UZ(zv[i], c) - UZ(zv[i + 1], c));
                    if (!PA) { const float r = UZ(zr[i + 1], c) + mur[c] * (UZ(zr[i], c) - UZ(zr[i + 1], c)); Rt[i] = r * E[i + 1]; rk[i] += r * km * rkp[c]; } }
                Atc[c] = pk4(At); Btc[c] = pk4(Bt); Ktc[c] = pk4(Kt); Vc[c] = pk4(Vv); if (!PA) Rtc[c] = pk4(Rt);
                }
            bf16x8 AtT[2], BtT[2], KtT[2], RtT[2];
#pragma unroll
            for (int ks = 0; ks < 2; ++ks) {
                AtT[ks] = pk8(MFMA16(Atc[2 * ks], idB, z4), MFMA16(Atc[2 * ks + 1], idB, z4));
                BtT[ks] = pk8(MFMA16(Btc[2 * ks], idB, z4), MFMA16(Btc[2 * ks + 1], idB, z4));
                KtT[ks] = pk8(MFMA16(Ktc[2 * ks], idB, z4), MFMA16(Ktc[2 * ks + 1], idB, z4));
                if (!PA) RtT[ks] = pk8(MFMA16(Rtc[2 * ks], idB, z4), MFMA16(Rtc[2 * ks + 1], idB, z4)); }
            f32x4 Nn = MFMA32(AtT[1], BtT[1], MFMA32(AtT[0], BtT[0], z4));
            f32x4 NT = MFMA32(BtT[1], AtT[1], MFMA32(BtT[0], AtT[0], z4));
            f32x4 Akt = MFMA32(KtT[1], AtT[1], MFMA32(KtT[0], AtT[0], z4));
#pragma unroll
            for (int i = 0; i < 4; ++i) { const int rr = 4 * g + i; if (!(n < rr)) Nn[i] = 0.f; if (!(rr < n)) { NT[i] = 0.f; Akt[i] = 0.f; } }
            bf16x4 pRB, pRK;
            if (!PA) { f32x4 Arbt = MFMA32(BtT[1], RtT[1], MFMA32(BtT[0], RtT[0], z4)), Arkt = MFMA32(KtT[1], RtT[1], MFMA32(KtT[0], RtT[0], z4));
#pragma unroll
                for (int i = 0; i < 4; ++i) if (!(4 * g + i <= n)) { Arbt[i] = 0.f; Arkt[i] = 0.f; }
                pRB = pk4(Arbt); pRK = pk4(Arkt); }
            const bf16x4 pN = pk4(Nn), pNT = pk4(NT), pAk = pk4(Akt);
            const f32x4 N2 = MFMA16(pNT, pN, z4), NT2 = MFMA16(pN, pNT, z4);
            const bf16x4 pN2 = pk4(N2), pNT2 = pk4(NT2);
            const f32x4 N4 = MFMA16(pNT2, pN2, z4), NT4 = MFMA16(pN2, pNT2, z4);
            const bf16x4 pN4 = pk4(N4), pNT4 = pk4(NT4);
            const bf16x4 pNT8 = pk4(MFMA16(pN4, pNT4, z4));
            __builtin_amdgcn_sched_barrier(0);
            f32x4 Y[4];
            {
                constexpr int hv = PP ? 1 : 0;
                f32x4 X[4];
#pragma unroll
                for (int v = 0; v < 4; ++v) { const int vc = v;
                    const bf16x8 Hb0 = pk8(H[0][vc], H[1][vc]), Hb1 = pk8(H[2][vc], H[3][vc]);
                    X[v] = MFMA32(AtT[1], Hb1, MFMA32(AtT[0], Hb0, z4));
                    if (hv == 0) X[v] = MFMA16(pAk, Vc[v], X[v]);
                    if (!PA) Y[v] = MFMA32(RtT[1], Hb1, MFMA32(RtT[0], Hb0, z4)); }
#pragma unroll
                for (int v = 0; v < 4; ++v) X[v] = MFMA16(pNT8, pk4(X[v]), X[v]);
#pragma unroll
                for (int v = 0; v < 4; ++v) X[v] = MFMA16(pNT4, pk4(X[v]), X[v]);
#pragma unroll
                for (int v = 0; v < 4; ++v) X[v] = MFMA16(pNT2, pk4(X[v]), X[v]);
#pragma unroll
                for (int v = 0; v < 4; ++v) X[v] = MFMA16(pNT, pk4(X[v]), X[v]);
                f32x4 g15[4];
#pragma unroll
                for (int c = 0; c < 4; ++c) g15[c] = __builtin_amdgcn_mfma_f32_16x16x4f32(g == 0 ? __expf(cle[c]) : 0.f, 1.f, z4, 0, 0, 0);
#pragma unroll
                for (int v = 0; v < 4; ++v) { const int vc = v; const bf16x4 pU = pk4(X[v]);
                    if (hv == 0) { const bf16x8 UV = cat8(pU, Vc[v]);
                        if (!PA) Y[v] = MFMA32(cat8(pRB, pRK), UV, Y[v]);
#pragma unroll
                        for (int kc = 0; kc < 4; ++kc) H[kc][vc] = MFMA32(cat8(Btc[kc], Ktc[kc]), UV, H[kc][vc]) * g15[kc]; }
                    else {
#pragma unroll
                        for (int kc = 0; kc < 4; ++kc) H[kc][vc] = MFMA16(Btc[kc], pU, H[kc][vc]) * g15[kc]; } }
                if (PA) {
#pragma unroll
                    for (int vp = 0; vp < 4; vp += 2) { f32x4 Hp[2][4], Xp[2];
#pragma unroll
                        for (int t = 0; t < 2; ++t)
#pragma unroll
                            for (int kc = 0; kc < 4; ++kc) Hp[t][kc] = *(const LAS f32x4*)(HP + ((kc * 4 + vp + t) * 64 + ln) * 4);
#pragma unroll
                        for (int t = 0; t < 2; ++t) Xp[t] = MFMA32(AtT[1], pk8(Hp[t][2], Hp[t][3]), MFMA32(AtT[0], pk8(Hp[t][0], Hp[t][1]), z4));
#pragma unroll
                        for (int t = 0; t < 2; ++t) Xp[t] = MFMA16(pNT8, pk4(Xp[t]), Xp[t]);
#pragma unroll
                        for (int t = 0; t < 2; ++t) Xp[t] = MFMA16(pNT4, pk4(Xp[t]), Xp[t]);
#pragma unroll
                        for (int t = 0; t < 2; ++t) Xp[t] = MFMA16(pNT2, pk4(Xp[t]), Xp[t]);
#pragma unroll
                        for (int t = 0; t < 2; ++t) Xp[t] = MFMA16(pNT, pk4(Xp[t]), Xp[t]);
#pragma unroll
                        for (int t = 0; t < 2; ++t) { const bf16x4 pU = pk4(Xp[t]);
#pragma unroll
                            for (int kc = 0; kc < 4; ++kc) *(LAS f32x4*)(HP + ((kc * 4 + vp + t) * 64 + ln) * 4) = MFMA16(Btc[kc], pU, Hp[t][kc]) * g15[kc]; } }
                }
            }
            __builtin_amdgcn_sched_barrier(0);
            if (!PA) {
                int le = LANEID_FRESH(); asm volatile("" : "+v"(le));
                const int ne = le & 15, ge = le >> 4, che = h * 64 + 4 * ne;
                {   const f32x4 lnw = *(const f32x4*)(ka->in[I_LNW] + d * DH + che), lnb = *(const f32x4*)(ka->in[I_LNB] + d * DH + che);
#pragma unroll
                    for (int i = 0; i < 4; ++i) { const float mean = sum16((Y[0][i] + Y[1][i]) + (Y[2][i] + Y[3][i])) * (1.f / 64.f);
                        float q = 0.f;
#pragma unroll
                        for (int v = 0; v < 4; ++v) { const float dv = Y[v][i] - mean; q += dv * dv; }
                        const float rs = rsqrtf(sum16(q) * (1.f / 64.f) + GN_EPS), rki = sum16(rk[i]);
#pragma unroll
                        for (int v = 0; v < 4; ++v) Y[v][i] = (Y[v][i] - mean) * rs * lnw[v] + lnb[v] + rki * bf2f((unsigned short)Vc[v][i]); } }
                __builtin_amdgcn_sched_barrier(0);
                f32x4 accg[4]; const bf16* gbase = GupT + ((size_t)((d * 8 + h) * 16) * 64 + le) * 8;
#pragma unroll
                for (int c = 0; c < 4; ++c) accg[c] = z4;
#pragma unroll
                for (int ks = 0; ks < 4; ++ks) { const bf16x8 ag = *(const LAS bf16x8*)(Ag + (16 * sg + ne) * 136 + 32 * ks + 8 * ge);
#pragma unroll
                    for (int c = 0; c < 4; ++c) accg[c] = MFMA32(ag, *(const bf16x8*)(gbase + (c * 4 + ks) * 512), accg[c]); }
#pragma unroll
                for (int i = 0; i < 4; ++i) { f32x4 o;
#pragma unroll
                    for (int v = 0; v < 4; ++v) o[v] = Y[v][i] * accg[v][i];
                    *(v2u*)(YC + (size_t)((d ? row0 + 255 - 16 * s4 - 4 * ge : row0 + 16 * s4 + 4 * ge) + i * stp) * YP + 512 + d * 512 + che) = __builtin_bit_cast(v2u, pk4(o)); }
            }
        }
        __syncthreads();
    }
    if (PA) {
#pragma unroll
        for (int kc = 0; kc < 4; ++kc) {
#pragma unroll
            for (int vc = 0; vc < 4; ++vc) *(v2u*)(QB + unit + ((kc * 4 + vc) * 64 + lane) * 4) = __builtin_bit_cast(v2u, pk4(H[kc][vc]));
#pragma unroll
            for (int ks = 0; ks < 2; ++ks) { f32x4 e0, e1;
#pragma unroll
                for (int jj = 0; jj < 4; ++jj) { const int src = 16 * (n >> 2) + 4 * g + jj;
                    e0[jj] = HP[((kc * 4 + 2 * ks) * 64 + src) * 4 + (n & 3)]; e1[jj] = HP[((kc * 4 + 2 * ks + 1) * 64 + src) * 4 + (n & 3)]; }
                *(bf16x8*)(PBH + unit + ((kc * 2 + ks) * 64 + lane) * 8) = pk8(e0, e1); } }
    }
}
constexpr int REPT = 1, REP0 = 1, REP3 = 1, REP4 = 1, REP5 = 1, REPG = 1, REP1 = 1, REPC = 1, REP7 = 1, REP12 = 1;
__global__ void __launch_bounds__(NTHR, 2) fwd(Args args) {
    extern __shared__ __attribute__((aligned(16))) unsigned char lds_raw[];
    LAS unsigned char* lds = (LAS unsigned char*)lds_raw;
    int bar_epoch = 0;
    const int wave_s = __builtin_amdgcn_readfirstlane(threadIdx.x >> 6);
    const int G = gridDim.x, bx = blockIdx.x;
    const int vcu = (G % 8 == 0) ? (bx % 8) * (G / 8) + bx / 8 : bx;
    const int NGW = G * NWAVES;
#define MKTID() (wave_s * 64 + LANEID_FRESH())
#define PHASE_IDS int tid = MKTID(); asm volatile("" : "+v"(tid)); const int lane = tid & 63, wave = __builtin_amdgcn_readfirstlane(tid >> 6), gw = vcu * NWAVES + wave; (void)gw; (void)lane;
#define PHASE_PTRS KArgs ka = (KArgs)__builtin_amdgcn_kernarg_segment_ptr(); asm volatile("" : "+s"(ka)); unsigned char* ws = ka->ws; unsigned char* dob = (unsigned char*)ka->out; \
    const float* xp = ka->in[I_XP]; const float* xs = ka->in[I_XS]; \
    float* MOD = (float*)(ws + WS_MOD); \
    bf16* WupT = (bf16*)(ws + WS_WUP); bf16* AupT = (bf16*)(ws + WS_AUP); bf16* GupT = (bf16*)(ws + WS_GUP); \
    bf16* HSB = (bf16*)(ws + WS_HS); bf16* PBH = (bf16*)(dob + DO_PB); bf16* QB = (bf16*)(dob + DO_QB); \
    bf16* WinT = (bf16*)(ws + WS_WIN); bf16* WoT = (bf16*)(ws + WS_WO); bf16* W1T = (bf16*)(ws + WS_W1); bf16* W2T = (bf16*)(ws + WS_W2); \
    bf16* Zr = (bf16*)(ws + WS_ZR); bf16* Zc = (bf16*)(ws + WS_ZC); \
    bf16* MIX = (bf16*)(ws + WS_MIX); bf16* XN2 = (bf16*)(ws + WS_XN2); bf16* FB = (bf16*)(ws + WS_F); \
    bf16* XN = (bf16*)(dob + DO_XN); bf16* YCAT = (bf16*)(dob + DO_YCAT); bf16* AHID = (bf16*)(dob + DO_AHID);
    const int lo = args.ph_lo, hi = args.ph_hi;
#define IN(k) (lo <= (k) && (k) < hi)
#define SEAM(k) do { if (IN(k) && IN((k) + 1)) { if ((k) == 0) cg::this_grid().sync(); else { \
        asm volatile("s_waitcnt vmcnt(0)" ::: "memory"); __syncthreads(); \
        if (MKTID() == 0) { unsigned* bw_ = (unsigned*)((KArgs)__builtin_amdgcn_kernarg_segment_ptr())->ws + WS_BAR / 4; \
            __builtin_amdgcn_fence(__ATOMIC_RELEASE, "agent"); asm volatile("s_waitcnt vmcnt(0)" ::: "memory"); \
            const unsigned e_ = (unsigned)(++bar_epoch), ng_ = (G % 8 == 0) ? 8u : 1u;                      \
            const unsigned old_ = __hip_atomic_fetch_add(bw_ + 64 * (ng_ == 8u ? (bx & 7) : 0), 1u, __ATOMIC_RELAXED, __HIP_MEMORY_SCOPE_AGENT); \
            if (old_ + 1u == e_ * ((unsigned)G / ng_)) { const unsigned t_ = __hip_atomic_fetch_add(bw_ + 64 * 8, 1u, __ATOMIC_RELAXED, __HIP_MEMORY_SCOPE_AGENT); \
                if (t_ + 1u == e_ * ng_) { for (unsigned q_ = 0; q_ < 8; ++q_) __hip_atomic_store(bw_ + 64 * (16 + q_), e_, __ATOMIC_RELAXED, __HIP_MEMORY_SCOPE_AGENT); } }     \
            unsigned* rel_ = bw_ + 64 * (16 + (ng_ == 8u ? (bx & 7) : 0)); unsigned sp_ = 0; \
            while (__hip_atomic_load(rel_, __ATOMIC_RELAXED, __HIP_MEMORY_SCOPE_AGENT) < e_ && ++sp_ < (1u << 24)) __builtin_amdgcn_s_sleep(1); \
            __builtin_amdgcn_fence(__ATOMIC_ACQUIRE, "agent"); asm volatile("s_waitcnt vmcnt(0)" ::: "memory"); } \
        __syncthreads(); } } } while (0)
#define XROW(m) ((m) < 16384 ? xp + (size_t)(m) * DM : xs + (size_t)((m) - 16384) * DM)

    for (int rep0 = 0; rep0 < REP0; ++rep0)
    if (IN(0)) { PHASE_PTRS PHASE_IDS
        if (bx == 0 && tid < 64) { for (int i = tid; i < 128; i += 64) __hip_atomic_store((unsigned*)(ws + WS_BAR) + 64 * i, 0u, __ATOMIC_RELAXED, __HIP_MEMORY_SCOPE_AGENT); }
        if (bx < 96) {
            LAS float* sc = (LAS float*)lds;
            for (int i = tid; i < 3072; i += NTHR) { const int s = i >> 10, k = i & 1023; const float c = (s < 2) ? ka->in[I_CP][s * 1024 + k] : ka->in[I_CS][k]; sc[i] = c / (1.f + __expf(-c)); }
            __syncthreads();
            const int col = bx * 64 + lane, k0 = wave * 128; const float* wa = ka->in[I_WADA];
            float a0 = 0.f, a1 = 0.f, a2 = 0.f;
#pragma unroll 32
            for (int k = k0; k < k0 + 128; ++k) { const float w = wa[(size_t)k * 6144 + col]; a0 += sc[k] * w; a1 += sc[1024 + k] * w; a2 += sc[2048 + k] * w; }
            LAS float* red = sc + 3072;
            red[(wave * 3 + 0) * 64 + lane] = a0; red[(wave * 3 + 1) * 64 + lane] = a1; red[(wave * 3 + 2) * 64 + lane] = a2;
            __syncthreads();
            if (tid < 192) { const int s = tid >> 6, l = tid & 63; float v = ka->in[I_BADA][bx * 64 + l];
#pragma unroll
                for (int w = 0; w < 8; ++w) v += red[(w * 3 + s) * 64 + l];
                MOD[s * 6144 + bx * 64 + l] = v; }
            __syncthreads();
        }
        LAS float* scr = (LAS float*)(lds + wave * 16384);
        constexpr int I_IN = 16 * (DIN / 32), I_O = 16 * 32, I_L = 16, I_G = 32;
        constexpr int NIT = I_IN + I_O;
        for (int it = gw; it < NIT; it += NGW) {
            int r = it;
            if (r < I_IN) { transpose_item(ka->in[I_WIN], DM, DIN, WinT, scr, r, lane, 0, 0, true); continue; } r -= I_IN;
            if (r < I_O) { transpose_item(ka->in[I_WOUT], DM, DM, WoT, scr, r, lane, YP, 0); if (r >= I_O / 2) transpose_item(ka->in[I_WOUT], DM, DM, WoT, scr, r, lane, YP, 512); continue; } r -= I_O;
            continue;
        }
        for (int q = gw * 64 + lane; q < 32768; q += NGW * 64) {
            const float* W; bf16* F; int KS, qq = q;
            if (qq < 8192) { W = ka->in[I_WUP]; F = WupT; KS = 2; } else if (qq < 16384) { qq -= 8192; W = ka->in[I_AUP]; F = AupT; KS = 2; } else { qq -= 16384; W = ka->in[I_GUP]; F = GupT; KS = 4; }
            const int ln = qq & 63, ks = (qq >> 6) % KS, rest = (qq >> 6) / KS, c = rest & 3, h = (rest >> 2) & 7, d = rest >> 5, n = ln & 15, g = ln >> 4;
            const float* src = W + ((size_t)d * (32 * KS) + 32 * ks + 8 * g) * DH + 64 * h + 4 * n + c;
            v4u o; o.x = pk2(src[0], src[DH]); o.y = pk2(src[2 * DH], src[3 * DH]); o.z = pk2(src[4 * DH], src[5 * DH]); o.w = pk2(src[6 * DH], src[7 * DH]);
            *(v4u*)(F + (size_t)qq * 8) = o;
        }
    }
    SEAM(0);

    if (IN(1)) { PHASE_PTRS PHASE_IDS
        for (int rep = 0; rep < REP1; ++rep)
        for (int rg = gw; rg < MTOK / 16; rg += NGW) {
            const int m0 = rg * 16; const float* modS = MOD + seq_id(m0) * 6144;
            f32x4 A[4], B[4];
#pragma unroll
            for (int j = 0; j < 4; ++j) { const int c = 4 * lane + 256 * j; const f32x4 g = *(const f32x4*)(ka->in[I_GPRE] + c), scv = *(const f32x4*)(modS + 1024 + c); A[j] = g * (1.f + scv); B[j] = *(const f32x4*)(modS + c); }
            for (int r = 0; r < 16; ++r) { const int m = m0 + r; const f32x4* xr = (const f32x4*)XROW(m) + lane;
                f32x4 v[4]; float ss = 0.f;
#pragma unroll
                for (int j = 0; j < 4; ++j) { v[j] = __builtin_nontemporal_load(xr + 64 * j); ss += (v[j].x * v[j].x + v[j].y * v[j].y) + (v[j].z * v[j].z + v[j].w * v[j].w); }
                const float rstd = rsqrtf(wave_sum(ss) * (1.f / DM) + NORM_EPS);
                v2u* o = (v2u*)(XN + (size_t)m * DM) + lane;
#pragma unroll
                for (int j = 0; j < 4; ++j) { const f32x4 h = v[j] * rstd * A[j] + B[j]; v2u w; w.x = pk2(h.x, h.y); w.y = pk2(h.z, h.w); o[64 * j] = w; }
            }
        }
    }
    SEAM(1);

    if (IN(2)) { PHASE_PTRS
        pg8::Gemm g{XN, WinT, MTOK, DIN, DM}; pg8::StaticOrder S; S.init(MTOK, DIN, G, bx);
        pg8::EpiB E{Zc, ZCP, 6, Zr, DR, 0, nullptr, 0u, 2};
        for (int rep = 0; rep < REPG; ++rep) pg8::gemm_phase<pg8::EpiB, pg8::StaticOrder, true, true>(lds, g, S, E, MKTID());
    }
    SEAM(2);

    if (IN(3)) { PHASE_PTRS
        for (int rep = 0; rep < REP3; ++rep)
        for (int u = bx; u < 256; u += G) scan_unit<1>(ka, lds, Zr, WupT, AupT, GupT, u >> 7, u & 127, PBH, QB, nullptr, nullptr, wave_s);
    }
    SEAM(3);

    if (IN(4)) { PHASE_PTRS PHASE_IDS
        for (int rep = 0; rep < REP4; ++rep)
        if (bx < 192 && wave == 0) {
            const int vc = bx & 3, h = (bx >> 2) & 7, ds = bx >> 5, d = ds & 1, s = ds >> 1;
            const int wb = (s == 0) ? 0 : (s == 1 ? 32 : 64), nwin = (s < 2) ? 32 : 64, nst = nwin - 1;
            f32x4 Hc[4]; bf16x8 Pr[3][4][2]; f32x4 Qr[3][4];
#pragma unroll
            for (int kc = 0; kc < 4; ++kc) Hc[kc] = (f32x4){0.f, 0.f, 0.f, 0.f};
#define PB_UNIT(w) ((size_t)((d * 128 + (d ? wb + nwin - 1 - (w) : wb + (w))) * 8 + h) * 4096)
#define PB_LOAD(slot, w) do { const size_t un_ = PB_UNIT(w); _Pragma("unroll") for (int kc = 0; kc < 4; ++kc) { Qr[slot][kc] = ld4bf(QB + un_ + ((kc * 4 + vc) * 64 + lane) * 4); \
        _Pragma("unroll") for (int ks = 0; ks < 2; ++ks) Pr[slot][kc][ks] = *(const bf16x8*)(PBH + un_ + ((kc * 2 + ks) * 64 + lane) * 8); } } while (0)
#define PB_STEP(slot, w) do { const size_t un_ = PB_UNIT(w); \
        _Pragma("unroll") for (int kc = 0; kc < 4; ++kc) *(v2u*)(HSB + un_ + ((kc * 4 + vc) * 64 + lane) * 4) = __builtin_bit_cast(v2u, pk4(Hc[kc])); \
        bf16x8 Hh[2], Hl[2]; \
        _Pragma("unroll") for (int ks = 0; ks < 2; ++ks) { Hh[ks] = pk8(Hc[2 * ks], Hc[2 * ks + 1]); f32x4 r0, r1; \
            _Pragma("unroll") for (int i = 0; i < 4; ++i) { r0[i] = Hc[2 * ks][i] - bf2f((unsigned short)Hh[ks][i]); r1[i] = Hc[2 * ks + 1][i] - bf2f((unsigned short)Hh[ks][4 + i]); } \
            Hl[ks] = pk8(r0, r1); } \
        _Pragma("unroll") for (int kc = 0; kc < 4; ++kc) { f32x4 acc = Qr[slot][kc]; \
            _Pragma("unroll") for (int ks = 0; ks < 2; ++ks) { acc = MFMA32(Pr[slot][kc][ks], Hh[ks], acc); acc = MFMA32(Pr[slot][kc][ks], Hl[ks], acc); } \
            Hc[kc] = acc; } \
        if ((w) + 3 < nst) PB_LOAD(slot, (w) + 3); } while (0)
            PB_LOAD(0, 0); PB_LOAD(1, 1); PB_LOAD(2, 2);
#pragma unroll 1
            for (int w = 0; w < nst; w += 3) {
                PB_STEP(0, w);
                if (w + 1 < nst) PB_STEP(1, w + 1);
                if (w + 2 < nst) PB_STEP(2, w + 2);
            }
            { const size_t un_ = PB_UNIT(nst);
#pragma unroll
              for (int kc = 0; kc < 4; ++kc) *(v2u*)(HSB + un_ + ((kc * 4 + vc) * 64 + lane) * 4) = __builtin_bit_cast(v2u, pk4(Hc[kc])); }
#undef PB_UNIT
#undef PB_LOAD
#undef PB_STEP
        }
    }
    SEAM(4);

    if (IN(5)) { PHASE_PTRS
        for (int rep = 0; rep < REP5; ++rep)
        for (int u = bx; u < 256; u += G) scan_unit<0>(ka, lds, Zr, WupT, AupT, GupT, u >> 7, u & 127, nullptr, nullptr, HSB, YCAT, wave_s);
        PHASE_IDS
        for (int rep = 0; rep < REPC; ++rep)
        for (int rg = vcu * 4 + (tid >> 7); rg < MTOK / 16; rg += G * 4) {
            const int m0 = rg * 16, sb = seq_beg(m0), se = seq_end(m0), c = 4 * (tid & 127);
            const float* cw = ka->in[I_CONVW]; const f32x4 cw0 = *(const f32x4*)(cw + c), cw1 = *(const f32x4*)(cw + 512 + c), cw2 = *(const f32x4*)(cw + 1024 + c);
            f32x4 p = {0.f, 0.f, 0.f, 0.f}, q;
            if (m0 - 1 >= sb) p = ld4bf(Zc + (size_t)(m0 - 1) * ZCP + 512 + c);
            q = ld4bf(Zc + (size_t)m0 * ZCP + 512 + c);
#pragma unroll 4
            for (int i = 0; i < 16; ++i) { const int m = m0 + i; f32x4 nx = {0.f, 0.f, 0.f, 0.f};
                if (m + 1 < se) nx = ld4bf(Zc + (size_t)(m + 1) * ZCP + 512 + c);
                const f32x4 y = ld4bf(Zc + (size_t)m * ZCP + c) * (cw0 * p + cw1 * q + cw2 * nx);
                v2u w; w.x = pk2(y.x, y.y); w.y = pk2(y.z, y.w); *(v2u*)(YCAT + (size_t)m * YP + c) = w; p = q; q = nx; }
        }
    }
    SEAM(5);

    if (IN(6)) { PHASE_PTRS
        pg8::Gemm g{YCAT, WoT, MTOK, DM, YP}; pg8::StaticOrder S; S.init(MTOK, DM, G, bx);
        pg8::EpiB E{MIX, DM, 1 << 20, nullptr, 0, 0};
        for (int rep = 0; rep < REPG; ++rep) pg8::gemm_phase<pg8::EpiB, pg8::StaticOrder, true, true>(lds, g, S, E, MKTID());
    }
    SEAM(6);

    if (IN(7)) { PHASE_PTRS PHASE_IDS
        LAS float* scr = (LAS float*)(lds + wave * 16384);
        constexpr int I_1 = 16 * (DFF / 32), I_2 = (DFF / 64) * 32;
        for (int rept = 0; rept < REPT; ++rept)
        for (int it = gw; it < I_1 + I_2; it += NGW) {
            if (it < I_1) transpose_item(ka->in[I_W1], DM, DFF, W1T, scr, it, lane); else transpose_item(ka->in[I_W2], DFF, DM, W2T, scr, it - I_1, lane);
        }
        for (int rep = 0; rep < REP7; ++rep)
        for (int rg = gw; rg < MTOK / 16; rg += NGW) {
            const int m0 = rg * 16; const float* modS = MOD + seq_id(m0) * 6144;
            f32x4 G1[4], A2[4], B2[4];
#pragma unroll
            for (int j = 0; j < 4; ++j) { const int c = 4 * lane + 256 * j;
                G1[j] = *(const f32x4*)(modS + 2048 + c) * *(const f32x4*)(ka->in[I_GPOST] + c);
                A2[j] = *(const f32x4*)(ka->in[I_GPRE2] + c) * (1.f + *(const f32x4*)(modS + 4096 + c)); B2[j] = *(const f32x4*)(modS + 3072 + c); }
            for (int r = 0; r < 16; ++r) { const int m = m0 + r; const f32x4* xr = (const f32x4*)XROW(m) + lane;
                f32x4 x[4], mx[4]; float ss = 0.f;
#pragma unroll
                for (int j = 0; j < 4; ++j) { x[j] = __builtin_nontemporal_load(xr + 64 * j); mx[j] = ld4bf(MIX + (size_t)m * DM + 4 * lane + 256 * j); ss += (mx[j].x * mx[j].x + mx[j].y * mx[j].y) + (mx[j].z * mx[j].z + mx[j].w * mx[j].w); }
                const float rs1 = rsqrtf(wave_sum(ss) * (1.f / DM) + NORM_EPS); float s2 = 0.f;
#pragma unroll
                for (int j = 0; j < 4; ++j) { x[j] = x[j] + G1[j] * mx[j] * rs1; s2 += (x[j].x * x[j].x + x[j].y * x[j].y) + (x[j].z * x[j].z + x[j].w * x[j].w); }
                const float rs2 = rsqrtf(wave_sum(s2) * (1.f / DM) + NORM_EPS);
                v2u* o = (v2u*)(XN2 + (size_t)m * DM) + lane; v2u* o1 = (v2u*)(MIX + (size_t)m * DM) + lane;
#pragma unroll
                for (int j = 0; j < 4; ++j) { const f32x4 hh = x[j] * rs2 * A2[j] + B2[j]; v2u w; w.x = pk2(hh.x, hh.y); w.y = pk2(hh.z, hh.w); o[64 * j] = w;
                    v2u w1; w1.x = pk2(x[j].x, x[j].y); w1.y = pk2(x[j].z, x[j].w); o1[64 * j] = w1; }
            }
        }
    }
    SEAM(7);

#pragma unroll 1
    for (int half = 0; half < 2; ++half) {
        if (IN(8 + 2 * half)) { PHASE_PTRS
            pg8::Gemm g{XN2 + (size_t)half * 16384 * DM, W1T, 16384, DFF, DM}; pg8::StaticOrder S; S.init(16384, DFF, G, bx);
            pg8::EpiB E{AHID, DFF, 1 << 20, nullptr, 0, 1, (unsigned*)(ws + WS_BAR) + 64 * 32, (unsigned)(16384u * DFF * 2u)};
            for (int rep = 0; rep < REPG; ++rep) pg8::gemm_phase<pg8::EpiB, pg8::StaticOrder, true, true>(lds, g, S, E, MKTID());
        }
        if (IN(9 + 2 * half)) { PHASE_PTRS
            pg8::Gemm g{AHID, W2T, 16384, DM, DFF}; pg8::CountedOrder S; S.init(16384, DM, G, bx);
            S.ready = (const unsigned*)(ws + WS_BAR) + 64 * 32; S.need = 128u * (unsigned)(half + 1); S.is_wave0 = (wave_s == 0);
            pg8::EpiB E{FB + (size_t)half * 16384 * DM, DM, 1 << 20, nullptr, 0, 0};
            for (int rep = 0; rep < REPG; ++rep) pg8::gemm_phase<pg8::EpiB, pg8::CountedOrder, false, true>(lds, g, S, E, MKTID());
        }
        SEAM(9 + 2 * half);
    }

    if (IN(12)) { PHASE_PTRS PHASE_IDS
        for (int rep = 0; rep < REP12; ++rep)
        for (int rg = gw; rg < MTOK / 16; rg += NGW) {
            const int m0 = rg * 16; const float* modS = MOD + seq_id(m0) * 6144;
            f32x4 G2[4];
#pragma unroll
            for (int j = 0; j < 4; ++j) { const int c = 4 * lane + 256 * j; G2[j] = *(const f32x4*)(modS + 5120 + c) * *(const f32x4*)(ka->in[I_GPOST2] + c); }
            for (int r = 0; r < 16; ++r) { const int m = m0 + r;
                f32x4 x1[4], fx[4]; float sf = 0.f;
#pragma unroll
                for (int j = 0; j < 4; ++j) { x1[j] = ld4bf_nt(MIX + (size_t)m * DM + 4 * lane + 256 * j); fx[j] = ld4bf_nt(FB + (size_t)m * DM + 4 * lane + 256 * j);
                    sf += (fx[j].x * fx[j].x + fx[j].y * fx[j].y) + (fx[j].z * fx[j].z + fx[j].w * fx[j].w); }
                const float rs3 = rsqrtf(wave_sum(sf) * (1.f / DM) + NORM_EPS);
                f32x4* o = (f32x4*)(ka->out + (size_t)m * DM) + lane;
#pragma unroll
                for (int j = 0; j < 4; ++j) __builtin_nontemporal_store(x1[j] + G2[j] * fx[j] * rs3, o + 64 * j);
            }
        }
    }
#undef IN
#undef SEAM
#undef XROW
}

constexpr int N_PHASES = 13;
extern "C" void kernel_launch(void* const* d_in, const int* in_sizes, int n_in, void* d_out, int out_size, void* d_ws, size_t ws_size, hipStream_t stream) {
    static int grid = 0;
    if (grid == 0) {
        if (n_in != 26 || out_size != MTOK * DM || ws_size < WS_NEED) { fprintf(stderr, "kernel_launch: unexpected shapes (n_in %d out %d ws %zu)\n", n_in, out_size, ws_size); grid = -1; return; }
        int dev = 0, cus = 0, per_cu = 0;
        hipGetDevice(&dev); hipDeviceGetAttribute(&cus, hipDeviceAttributeMultiprocessorCount, dev);
        if (hipFuncSetAttribute((const void*)fwd, hipFuncAttributeMaxDynamicSharedMemorySize, LDS_BYTES) != hipSuccess) { fprintf(stderr, "kernel_launch: hipFuncSetAttribute failed\n"); grid = -1; return; }
        if (hipOccupancyMaxActiveBlocksPerMultiprocessor(&per_cu, (const void*)fwd, NTHR, LDS_BYTES) != hipSuccess || per_cu < 1) { fprintf(stderr, "kernel_launch: occupancy query failed (%d)\n", per_cu); per_cu = 1; }
        (void)hipGetLastError();
        grid = cus * per_cu; if (grid > 256) grid = 256;
        fprintf(stderr, "kernel_launch: grid %d (cus %d per_cu %d)\n", grid, cus, per_cu);
    }
    if (grid < 0) return;
    Args a{};
    for (int i = 0; i < 26; ++i) a.in[i] = (const float*)d_in[i];
    a.out = (float*)d_out; a.ws = (unsigned char*)d_ws; a.ph_lo = 0; a.ph_hi = N_PHASES;
    void* kargs[] = {&a};
    hipError_t e = hipLaunchCooperativeKernel((const void*)fwd, dim3(grid), dim3(NTHR), kargs, LDS_BYTES, stream);
    if (e != hipSuccess) fprintf(stderr, "kernel_launch: cooperative launch failed: %s (grid %d)\n", hipGetErrorString(e), grid);
}
```

```cpp
#include <hip/hip_runtime.h>
#include <hip/hip_cooperative_groups.h>
#include <cstdio>
#include <cstdint>
namespace cg = cooperative_groups;
namespace pg8 {
#define PG8_LAS __attribute__((address_space(3)))
typedef unsigned short bf16_t;
typedef short bf16x8 __attribute__((ext_vector_type(8)));
typedef float f32x4 __attribute__((ext_vector_type(4)));
typedef unsigned u32x4 __attribute__((ext_vector_type(4)));
constexpr int BM = 256, BK = 64, HALF = 128, HTB = HALF * BK * 2  , STAGE_BYTES = 8 * HTB, NXCD = 8, WGM = 8;

__host__ __device__ __forceinline__ int lds_byte(int r, int c) { const int st = (r >> 4) * 2 + (c >> 5), rr = r & 15, cc = c & 31, ob = rr * 64 + cc * 2; return st * 1024 + (ob ^ (((ob >> 9) & 1) << 5)); }
__host__ __device__ __forceinline__ void stage_rc(int b, int& R, int& C) { const int st = b / 1024, sb = b % 1024, swz = sb ^ (((sb >> 9) & 1) << 5); R = (st >> 1) * 16 + swz / 64; C = (st & 1) * 32 + (swz % 64) / 2; }
__host__ __device__ __forceinline__ int perm32(int rho) { const int n = rho >> 4, i = rho & 15; return 8 * (i >> 2) + 4 * n + (i & 3); }

struct Unit { int pm, pn; };
struct Gemm { const bf16_t* A; const bf16_t* Bt; int M, N, K; };

struct StaticOrder {
    int nM, nN, nwg, G, c;
    __host__ __device__ void init(int M, int N, int G_, int c_) { nM = M / BM; nN = N / BM; nwg = nM * nN; G = G_; c = c_; }
    __host__ __device__ bool next(int i, Unit& u) const {
        const long L = (long)i * G + c; if (L >= nwg) return false;
        int wgid = (int)L; { const int q = nwg / NXCD, r = nwg % NXCD, xcd = wgid % NXCD, off = wgid / NXCD; wgid = (xcd < r ? xcd * (q + 1) : r * (q + 1) + (xcd - r) * q) + off; }
        const int nig = WGM * nN, gid = wgid / nig, fm = gid * WGM, gsz = (nM - fm) < WGM ? (nM - fm) : WGM;
        u.pm = fm + ((wgid % nig) % gsz); u.pn = (wgid % nig) / gsz; return true;
    }
    __device__ __forceinline__ void a_ready(const Unit&) const {}
    __device__ __forceinline__ void done(const Unit&) const {}
};
typedef __bf16 hbf2_t __attribute__((ext_vector_type(2)));
typedef float f32x2_t __attribute__((ext_vector_type(2)));
__device__ __forceinline__ unsigned cvt_pk_bf16(float lo, float hi) { const f32x2_t v = {lo, hi}; const hbf2_t b = __builtin_convertvector(v, hbf2_t); return __builtin_bit_cast(unsigned, b); }
template <class Epi, class Sched, bool ALIGN_EPI = false, bool SP2 = false>
__device__ __forceinline__ void gemm_phase(PG8_LAS unsigned char* lds, const Gemm g, const Sched& S, const Epi& E, const int tid_in) {
    int tid = tid_in; asm volatile("" : "+v"(tid)); const int wid = __builtin_amdgcn_readfirstlane(tid >> 6), lane = tid & 63, wr = wid >> 2, wc = wid & 3, fr = lane & 15, fq = lane >> 4;
    const int K = g.K, nt = K / BK;
    unsigned voffA[2], voffB[2];
#pragma unroll
    for (int i = 0; i < 2; ++i) { int R, C; stage_rc(tid * 16 + i * 8192, R, C); const int Rb = Epi::PERM ? ((R & ~31) + perm32(R & 31)) : R;
        voffA[i] = (unsigned)(R * K + C) * 2u; voffB[i] = (unsigned)(Rb * K + C) * 2u; }
    const size_t kstep = (size_t)(BK * 2);
    const size_t hstep = (size_t)HALF * K * 2;
    const size_t tstep = 2 * hstep;
    const unsigned ldsw = (unsigned)wid * 1024u;
    const int aoff = lds_byte(wr * 64 + fr, fq * 8), boff = lds_byte(wc * 32 + fr, fq * 8);
#define PG8_SA(b, h) (((b) * 2 + (h)) * HTB)
#define PG8_SB(b, h) ((4 + (b) * 2 + (h)) * HTB)
#define PG8_STAGE(bufoff, gbase, voff) do { _Pragma("unroll") for (int _i = 0; _i < 2; ++_i) \
        __builtin_amdgcn_global_load_lds((const unsigned*)((const char*)(gbase) + (voff)[_i]), (PG8_LAS unsigned*)(lds + (bufoff) + ldsw + _i * 8192), 16, 0, 0); } while (0)
#define PG8_LDA(dst, b, h) do { _Pragma("unroll") for (int m = 0; m < 4; ++m) _Pragma("unroll") for (int k = 0; k < 2; ++k) dst[m][k] = *(const PG8_LAS bf16x8*)(lds + PG8_SA(b, h) + aoff + m * 2048 + k * 1024); } while (0)
#define PG8_LDB(dst, b, h) do { _Pragma("unroll") for (int n = 0; n < 2; ++n) _Pragma("unroll") for (int k = 0; k < 2; ++k) dst[n][k] = *(const PG8_LAS bf16x8*)(lds + PG8_SB(b, h) + boff + n * 2048 + k * 1024); } while (0)
#define PG8_MMA(ai, bj, At, Bt) do { __builtin_amdgcn_s_setprio(1); _Pragma("unroll") for (int m = 0; m < 4; ++m) _Pragma("unroll") for (int n = 0; n < 2; ++n) _Pragma("unroll") for (int k = 0; k < 2; ++k) \
        acc[ai][bj][m][n] = __builtin_amdgcn_mfma_f32_16x16x32_bf16(Bt[n][k], At[m][k], acc[ai][bj][m][n], 0, 0, 0); __builtin_amdgcn_s_setprio(0); } while (0)
#define PG8_WAIT_V(n) asm volatile("s_waitcnt vmcnt(" #n ")" ::: "memory")
#define PG8_WAIT_L(n) asm volatile("s_waitcnt lgkmcnt(" #n ")" ::: "memory")
#define PG8_BAR __builtin_amdgcn_s_barrier()
#define PG8_SCHED __builtin_amdgcn_sched_barrier(0)
    Unit cur, nxt; int ui = 0;
    if (!S.next(0, cur)) return;
    f32x4 acc[2][2][4][2];
#pragma unroll
    for (int a = 0; a < 2; ++a)
#pragma unroll
        for (int b = 0; b < 2; ++b)
#pragma unroll
            for (int m = 0; m < 4; ++m)
#pragma unroll
                for (int n = 0; n < 2; ++n) acc[a][b][m][n] = (f32x4){0.f, 0.f, 0.f, 0.f};
    bf16x8 At[4][2], B0[2][2], B1[2][2];
    const char* cA = (const char*)g.A + (size_t)cur.pm * tstep; const char* cB = (const char*)g.Bt + (size_t)cur.pn * tstep;
    S.a_ready(cur);
    if constexpr (SP2) {
        PG8_STAGE(PG8_SB(0, 0), cB, voffB); PG8_STAGE(PG8_SB(0, 1), cB + hstep, voffB); PG8_STAGE(PG8_SA(0, 0), cA, voffA); PG8_STAGE(PG8_SA(0, 1), cA + hstep, voffA);
        if (wr == 1) PG8_BAR;
        PG8_WAIT_V(2); PG8_BAR;
        PG8_STAGE(PG8_SB(1, 0), cB + kstep, voffB); PG8_STAGE(PG8_SA(1, 0), cA + kstep, voffA); PG8_STAGE(PG8_SB(1, 1), cB + hstep + kstep, voffB);
        PG8_WAIT_V(6); PG8_BAR;
    } else {
        PG8_STAGE(PG8_SB(0, 0), cB, voffB); PG8_STAGE(PG8_SA(0, 0), cA, voffA); PG8_STAGE(PG8_SB(0, 1), cB + hstep, voffB); PG8_STAGE(PG8_SA(0, 1), cA + hstep, voffA);
        if (wr == 1) PG8_BAR;
        PG8_WAIT_V(4); PG8_BAR;
        PG8_STAGE(PG8_SB(1, 0), cB + kstep, voffB); PG8_STAGE(PG8_SA(1, 0), cA + kstep, voffA); PG8_STAGE(PG8_SB(1, 1), cB + hstep + kstep, voffB);
        PG8_WAIT_V(6); PG8_BAR;
    }
    for (;;) {
        const bool has_next = S.next(ui + 1, nxt);
        const char* nA = has_next ? (const char*)g.A + (size_t)nxt.pm * tstep : cA; const char* nB = has_next ? (const char*)g.Bt + (size_t)nxt.pn * tstep : cB;
        for (int t = 0; t < nt; t += 2) {
            const bool last = (t == nt - 2);
            const char* a1 = cA + (size_t)(t + 1) * kstep;
            const char* a2 = last ? nA : cA + (size_t)(t + 2) * kstep; const char* b2 = last ? nB : cB + (size_t)(t + 2) * kstep;
            const char* a3 = a2 + kstep; const char* b3 = b2 + kstep;
            if (last && has_next) S.a_ready(nxt);
            if constexpr (SP2) {
            PG8_LDB(B0, 0, 0); PG8_LDB(B1, 0, 1); PG8_SCHED; PG8_LDA(At, 0, 0); PG8_STAGE(PG8_SA(1, 1), a1 + hstep, voffA);
            PG8_WAIT_V(8); PG8_WAIT_L(0); PG8_BAR; PG8_MMA(0, 0, At, B0); PG8_MMA(0, 1, At, B1); PG8_BAR; PG8_SCHED;
            PG8_LDA(At, 0, 1); PG8_STAGE(PG8_SB(0, 0), b2, voffB); PG8_STAGE(PG8_SB(0, 1), b2 + hstep, voffB); PG8_STAGE(PG8_SA(0, 0), a2, voffA);
            PG8_WAIT_V(8); PG8_WAIT_L(0); PG8_BAR; PG8_MMA(1, 0, At, B0); PG8_MMA(1, 1, At, B1); PG8_BAR; PG8_SCHED;
            PG8_LDB(B0, 1, 0); PG8_LDB(B1, 1, 1); PG8_SCHED; PG8_LDA(At, 1, 0); PG8_STAGE(PG8_SA(0, 1), a2 + hstep, voffA);
            PG8_WAIT_V(8); PG8_WAIT_L(0); PG8_BAR; PG8_MMA(0, 0, At, B0); PG8_MMA(0, 1, At, B1); PG8_BAR; PG8_SCHED;
            PG8_LDA(At, 1, 1); PG8_STAGE(PG8_SB(1, 0), b3, voffB); PG8_STAGE(PG8_SB(1, 1), b3 + hstep, voffB); PG8_STAGE(PG8_SA(1, 0), a3, voffA);
            PG8_WAIT_V(8); PG8_WAIT_L(0); PG8_BAR; PG8_MMA(1, 0, At, B0); PG8_MMA(1, 1, At, B1); PG8_BAR; PG8_SCHED;
            } else {
            PG8_LDB(B0, 0, 0); PG8_SCHED; PG8_LDA(At, 0, 0); PG8_STAGE(PG8_SA(1, 1), a1 + hstep, voffA);
            PG8_WAIT_L(8); PG8_BAR; PG8_WAIT_L(0); PG8_MMA(0, 0, At, B0); PG8_BAR; PG8_SCHED;
            PG8_LDB(B1, 0, 1); PG8_STAGE(PG8_SB(0, 0), b2, voffB);
            PG8_BAR; PG8_WAIT_L(0); PG8_MMA(0, 1, At, B1); PG8_BAR;
            PG8_LDA(At, 0, 1); PG8_STAGE(PG8_SA(0, 0), a2, voffA);
            PG8_BAR; PG8_WAIT_L(0); PG8_MMA(1, 0, At, B0); PG8_BAR; PG8_SCHED;
            PG8_STAGE(PG8_SB(0, 1), b2 + hstep, voffB);
            PG8_WAIT_V(6); PG8_BAR; PG8_MMA(1, 1, At, B1); PG8_BAR;
            PG8_LDB(B0, 1, 0); PG8_SCHED; PG8_LDA(At, 1, 0); PG8_STAGE(PG8_SA(0, 1), a2 + hstep, voffA);
            PG8_WAIT_L(8); PG8_BAR; PG8_WAIT_L(0); PG8_MMA(0, 0, At, B0); PG8_BAR; PG8_SCHED;
            PG8_LDB(B1, 1, 1); PG8_STAGE(PG8_SB(1, 0), b3, voffB);
            PG8_BAR; PG8_WAIT_L(0); PG8_MMA(0, 1, At, B1); PG8_BAR;
            PG8_LDA(At, 1, 1); PG8_STAGE(PG8_SA(1, 0), a3, voffA);
            PG8_BAR; PG8_WAIT_L(0); PG8_MMA(1, 0, At, B0); PG8_BAR; PG8_SCHED;
            PG8_STAGE(PG8_SB(1, 1), b3 + hstep, voffB);
            PG8_WAIT_V(6); PG8_BAR; PG8_MMA(1, 1, At, B1); PG8_BAR;
            }
        }
        if constexpr (ALIGN_EPI) { if (wr == 0) PG8_BAR; }
        if constexpr (!Epi::AFTER_DRAIN) { E(acc, cur, wr, wc, fr, fq); S.done(cur); }
        if (!has_next) break;
#pragma unroll
        for (int a = 0; a < 2; ++a)
#pragma unroll
            for (int b = 0; b < 2; ++b)
#pragma unroll
                for (int m = 0; m < 4; ++m)
#pragma unroll
                    for (int n = 0; n < 2; ++n) acc[a][b][m][n] = (f32x4){0.f, 0.f, 0.f, 0.f};
        cur = nxt; cA = nA; cB = nB; ++ui;
        if constexpr (ALIGN_EPI) { if (wr == 1) PG8_BAR; }
    }
    PG8_WAIT_V(0);
    if constexpr (!ALIGN_EPI) { if (wr == 0) PG8_BAR; }
    PG8_BAR;
    if constexpr (Epi::AFTER_DRAIN) { E.fused(acc, cur, wr, wc, fr, fq, lds, wid, lane); S.done(cur); }
#undef PG8_SA
#undef PG8_SB
#undef PG8_STAGE
#undef PG8_LDA
#undef PG8_LDB
#undef PG8_MMA
#undef PG8_WAIT_V
#undef PG8_WAIT_L
#undef PG8_BAR
#undef PG8_SCHED
}
}
namespace pg8 {
struct EpiB {
    static constexpr bool PERM = true, AFTER_DRAIN = false;
    bf16_t* O0; int ld0; int split; bf16_t* O1; int ld1; int act;
    unsigned* ready; unsigned nbytes; int cu_lo; int nt;
    __device__ __forceinline__ void operator()(const f32x4 (&acc)[2][2][4][2], const Unit& u, int wr, int wc, int fr, int fq) const {
        const int row0 = u.pm * BM + wr * 64 + fr;
        if (cu_lo > 0 && u.pn >= cu_lo && u.pn < split) {
            const int colc = 512 + 128 * (u.pn - cu_lo) + wc * 32 + 8 * fq;
#pragma unroll
            for (int ai = 0; ai < 2; ++ai)
#pragma unroll
                for (int m = 0; m < 4; ++m) { const f32x4 v0 = acc[ai][0][m][0] * acc[ai][1][m][0], v1 = acc[ai][0][m][1] * acc[ai][1][m][1];
                    u32x4 w; w.x = cvt_pk_bf16(v0[0], v0[1]); w.y = cvt_pk_bf16(v0[2], v0[3]); w.z = cvt_pk_bf16(v1[0], v1[1]); w.w = cvt_pk_bf16(v1[2], v1[3]);
                    *(u32x4*)(O0 + (size_t)(row0 + ai * HALF + m * 16) * ld0 + colc) = w; }
            return; }
        bf16_t* base; int ld, colt;
        if (u.pn < split) { base = O0; ld = ld0; colt = u.pn * BM; } else { base = O1; ld = ld1; colt = (u.pn - split) * BM; }
        const int col0 = colt + wc * 32 + 8 * fq;
#pragma unroll
        for (int ai = 0; ai < 2; ++ai)
#pragma unroll
            for (int m = 0; m < 4; ++m) { bf16_t* rowp = base + (size_t)(row0 + ai * HALF + m * 16) * ld + col0;
#pragma unroll
                for (int bj = 0; bj < 2; ++bj) { f32x4 v0 = acc[ai][bj][m][0], v1 = acc[ai][bj][m][1];
                    if (act) {
#pragma unroll
                        for (int e = 0; e < 4; ++e) { float a = fmaxf(v0[e], 0.f), b = fmaxf(v1[e], 0.f); v0[e] = a * a; v1[e] = b * b; } }
                    u32x4 w; w.x = cvt_pk_bf16(v0[0], v0[1]); w.y = cvt_pk_bf16(v0[2], v0[3]); w.z = cvt_pk_bf16(v1[0], v1[1]); w.w = cvt_pk_bf16(v1[2], v1[3]);
                    if (ready) __builtin_amdgcn_raw_buffer_store_b128(w, __builtin_amdgcn_make_buffer_rsrc(O0, 0, (int)nbytes, 0x00020000), (unsigned)((size_t)((rowp + bj * HALF) - O0) * 2), 0,   16);
                    else if (nt) __builtin_nontemporal_store(w, (u32x4*)(rowp + bj * HALF));
                    else *(u32x4*)(rowp + bj * HALF) = w; } }
        if (ready) {
            asm volatile("s_waitcnt vmcnt(0)" ::: "memory");
            if (fr == 0 && fq == 0) __hip_atomic_fetch_add(ready + 64 * u.pm, 1u, __ATOMIC_RELAXED, __HIP_MEMORY_SCOPE_AGENT); }
    }
};
struct CountedOrder : StaticOrder {
    const unsigned* ready; unsigned need; int is_wave0;
    __device__ __forceinline__ void a_ready(const Unit& u) const {
        if (is_wave0) { unsigned polls = 0;
            while ((unsigned)__builtin_amdgcn_readfirstlane(__hip_atomic_load(ready + 64 * u.pm, __ATOMIC_RELAXED, __HIP_MEMORY_SCOPE_AGENT)) < need && ++polls < (1u << 22)) __builtin_amdgcn_s_sleep(2);
            __builtin_amdgcn_fence(__ATOMIC_ACQUIRE, "agent");
            asm volatile("s_waitcnt vmcnt(0)" ::: "memory"); }
        asm volatile("" ::: "memory"); __builtin_amdgcn_s_barrier(); asm volatile("" ::: "memory");
    }
};
}
constexpr int NWAVES = 8, NTHR = 512;
constexpr int DM = 1024, MTOK = 32768, DIN = 3328, DC3 = 1536, ZCP = 1024, DR = 1792, DFF = 4096, DH = 512;
constexpr int LDS_BYTES = 163840;
constexpr float NORM_EPS = 1e-6f, GN_EPS = 64e-5f;
constexpr size_t MiB = 1u << 20;
constexpr size_t WS_MOD = 0, WS_BAR = 512 * 1024, WS_WUP = 1 * MiB, WS_AUP = WS_WUP + 131072, WS_GUP = WS_AUP + 131072;
constexpr size_t WS_WIN = 3 * MiB, WS_WO = 9 * MiB + 512 * 1024, WS_ZR = 13 * MiB, WS_ZC = 125 * MiB, WS_HS = 221 * MiB;
constexpr size_t WS_W1 = 13 * MiB, WS_W2 = 21 * MiB, WS_MIX = 32 * MiB, WS_XN2 = 96 * MiB, WS_F = 160 * MiB;
constexpr size_t WS_NEED = 253 * MiB;
constexpr size_t DO_XN = 0, DO_YCAT = 0, DO_PB = 0, DO_QB = 32 * MiB, DO_AHID = 0;

typedef unsigned short bf16;
typedef unsigned v4u __attribute__((ext_vector_type(4)));
typedef unsigned v2u __attribute__((ext_vector_type(2)));
typedef float f32x4 __attribute__((ext_vector_type(4)));
typedef short bf16x8 __attribute__((ext_vector_type(8)));
#define LAS __attribute__((address_space(3)))
#define LANEID_FRESH() ({ unsigned m_ = ~0u; asm volatile("" : "+s"(m_)); (int)__builtin_amdgcn_mbcnt_hi(m_, __builtin_amdgcn_mbcnt_lo(m_, 0u)); })
#define LDS_WAIT() asm volatile("s_waitcnt lgkmcnt(0)" ::: "memory")

__device__ __forceinline__ unsigned f2bf(float f) { unsigned u = __builtin_bit_cast(unsigned, f); return (u + 0x7fffu + ((u >> 16) & 1u)) >> 16; }
__device__ __forceinline__ unsigned pk2(float lo, float hi) { return f2bf(lo) | (f2bf(hi) << 16); }
__device__ __forceinline__ float bf2f(unsigned u) { return __builtin_bit_cast(float, u << 16); }
__device__ __forceinline__ f32x4 ld4bf(const bf16* p) { const v2u w = *(const v2u*)p; f32x4 r; r.x = bf2f(w.x & 0xffffu); r.y = __builtin_bit_cast(float, w.x & 0xffff0000u); r.z = bf2f(w.y & 0xffffu); r.w = __builtin_bit_cast(float, w.y & 0xffff0000u); return r; }
__device__ __forceinline__ f32x4 ld4bf_nt(const bf16* p) { const v2u w = __builtin_nontemporal_load((const v2u*)p); f32x4 r; r.x = bf2f(w.x & 0xffffu); r.y = __builtin_bit_cast(float, w.x & 0xffff0000u); r.z = bf2f(w.y & 0xffffu); r.w = __builtin_bit_cast(float, w.y & 0xffff0000u); return r; }
__device__ __forceinline__ float wave_sum(float v) {
#pragma unroll
    for (int o = 1; o < 64; o <<= 1) v += __shfl_xor(v, o);
    return v;
}
template <int CTRL> __device__ __forceinline__ float dpp_mov(float x) { return __builtin_bit_cast(float, __builtin_amdgcn_update_dpp(0, __builtin_bit_cast(int, x), CTRL, 0xf, 0xf, true)); }
__device__ __forceinline__ float sum16(float x) { x += dpp_mov<0xB1>(x); x += dpp_mov<0x4E>(x); x += dpp_mov<0x124>(x); x += dpp_mov<0x128>(x); return x; }
__device__ __forceinline__ float sigmoidf_(float x) { return 1.f / (1.f + __expf(-x)); }
__device__ __forceinline__ int seq_beg(int m) { return m < 8192 ? 0 : (m < 16384 ? 8192 : 16384); }
__device__ __forceinline__ int seq_end(int m) { return m < 8192 ? 8192 : (m < 16384 ? 16384 : 32768); }
__device__ __forceinline__ int seq_id(int m) { return m < 8192 ? 0 : (m < 16384 ? 1 : 2); }

struct Args { const float* in[26]; float* out; unsigned char* ws; int ph_lo, ph_hi; };
typedef const __attribute__((address_space(4))) Args* KArgs;
enum { I_XP = 0, I_XS, I_CP, I_CS, I_WADA, I_BADA, I_GPRE, I_GPOST, I_WIN, I_CONVW, I_MU, I_W0, I_WUP, I_A0, I_AUP, I_GUP, I_KK, I_KA, I_RK, I_LNW, I_LNB, I_WOUT, I_GPRE2, I_GPOST2, I_W1, I_W2 };

__device__ __forceinline__ void transpose_item(const float* W, int K, int N, bf16* WT, LAS float* scr, int item, int lane, int ldk = 0, int kdst = 0, bool convperm = false) {
    if (ldk == 0) ldk = K;
    const int nblk = N / 32, kb = item / nblk, nb = item % nblk, k0 = 64 * kb, n0 = 32 * nb;
    int dn0 = n0; if (convperm && n0 >= 512 && n0 < 1536) { const int isu = n0 >= 1024, ch = n0 - (isu ? 1024 : 512); dn0 = 512 + 256 * (ch >> 7) + 128 * isu + (ch & 127); }
    float tv[32];
#pragma unroll
    for (int i = 0; i < 32; ++i) tv[i] = __builtin_nontemporal_load(W + (size_t)(k0 + 2 * i + (lane >> 5)) * N + n0 + (lane & 31));
#pragma unroll
    for (int i = 0; i < 32; ++i) scr[(2 * i + (lane >> 5)) * 33 + (lane & 31)] = tv[i];
    LDS_WAIT();
    const int c = lane & 7;
#pragma unroll
    for (int j = 0; j < 4; ++j) { const int n = (lane >> 3) + 8 * j; const LAS float* s = scr + (8 * c) * 33 + n;
        v4u o; o.x = pk2(s[0 * 33], s[1 * 33]); o.y = pk2(s[2 * 33], s[3 * 33]); o.z = pk2(s[4 * 33], s[5 * 33]); o.w = pk2(s[6 * 33], s[7 * 33]);
        *(v4u*)(WT + (size_t)(dn0 + n) * ldk + kdst + k0 + 8 * c) = o; }
    LDS_WAIT();
}

typedef short bf16x4 __attribute__((ext_vector_type(4)));
typedef __bf16 hbf2 __attribute__((ext_vector_type(2)));
typedef float f32x2_ __attribute__((ext_vector_type(2)));
__device__ __forceinline__ unsigned cvtpk(float lo, float hi) { const f32x2_ v = {lo, hi}; const hbf2 b = __builtin_convertvector(v, hbf2); return __builtin_bit_cast(unsigned, b); }
__device__ __forceinline__ bf16x4 pk4(f32x4 v) { v2u w; w.x = cvtpk(v.x, v.y); w.y = cvtpk(v.z, v.w); return __builtin_bit_cast(bf16x4, w); }
__device__ __forceinline__ bf16x8 pk8(f32x4 a, f32x4 b) { v4u w; w.x = cvtpk(a.x, a.y); w.y = cvtpk(a.z, a.w); w.z = cvtpk(b.x, b.y); w.w = cvtpk(b.z, b.w); return __builtin_bit_cast(bf16x8, w); }
__device__ __forceinline__ bf16x8 cat8(bf16x4 a, bf16x4 b) { return __builtin_shufflevector(a, b, 0, 1, 2, 3, 4, 5, 6, 7); }
#define BPERM(src, v) __builtin_bit_cast(float, __builtin_amdgcn_ds_bpermute(((src) & 63) << 2, __builtin_bit_cast(int, (v))))
#define MFMA32(a, b, c) __builtin_amdgcn_mfma_f32_16x16x32_bf16(a, b, c, 0, 0, 0)
#define MFMA16(a, b, c) __builtin_amdgcn_mfma_f32_16x16x16bf16_1k(a, b, c, 0, 0, 0)
#ifndef DBG_NOHS
#define DBG_NOHS 0
#endif
constexpr int YP = 1536;

template <int MODE>
__device__ __forceinline__ void scan_unit(KArgs ka, LAS unsigned char* lds, const bf16* Zr_in, const bf16* WupT, const bf16* AupT, const bf16* GupT,
                                          const int d, const int wrow, bf16* PBH, bf16* QB, const bf16* HS, bf16* YC, const int wave_s) {
    constexpr bool PA = (MODE != 0), PP = (MODE == 2); constexpr int NTL = 4;
    typedef const __attribute__((address_space(1))) bf16* gbf16p;
    gbf16p Zr = (gbf16p)Zr_in; asm volatile("" : "+s"(Zr));
    int tid = wave_s * 64 + LANEID_FRESH(); asm volatile("" : "+v"(tid));
    const int lane = tid & 63, h = __builtin_amdgcn_readfirstlane(tid >> 6), n = lane & 15, g = lane >> 4;
    const int row0 = wrow * 256, sb = seq_beg(row0), se = seq_end(row0);
    const int chb = h * 64 + 4 * n;
    const size_t unit = (size_t)((d * 128 + wrow) * 8 + h) * 4096;
    const f32x4 z4 = {0.f, 0.f, 0.f, 0.f};
    constexpr int TG = PA ? 64 : 256, NG = 256 / TG, SPG = TG / 16;
    LAS bf16* Aw = (LAS bf16*)lds; LAS bf16* Aa = Aw + TG * 72; LAS bf16* Ag = Aa + TG * 72;
    LAS float* HP = (LAS float*)(lds + 20480) + h * 4096;
    const int stp = d ? -1 : 1;
    f32x4 H[4][NTL];
#pragma unroll
    for (int kc = 0; kc < 4; ++kc)
#pragma unroll
        for (int vc = 0; vc < NTL; ++vc) {
            if (PA) { H[kc][vc] = z4; f32x4 idt;
#pragma unroll
                for (int i = 0; i < 4; ++i) idt[i] = (16 * g + 4 * i + kc == 4 * n + vc) ? 1.f : 0.f;
                *(LAS f32x4*)(HP + ((kc * 4 + vc) * 64 + lane) * 4) = idt; }
            else H[kc][vc] = ld4bf(HS + unit + ((kc * 4 + vc) * 64 + lane) * 4);
        }
#pragma unroll 1
    for (int grp = 0; grp < NG; ++grp) {
        {
            int tl = wave_s * 64 + LANEID_FRESH(); asm volatile("" : "+v"(tl));
            constexpr int QPR = PA ? 32 : 64, ITS = TG * QPR / NTHR;
#pragma unroll 2
            for (int it = 0; it < ITS; ++it) { const int e = tl + NTHR * it, tok = e / QPR, col = 4 * (e % QPR), jj = grp * TG + tok;
                const int m = d ? row0 + 255 - jj : row0 + jj, mp = m - stp, zc = 1536 + col;
                const f32x4 cur = ld4bf((const bf16*)(Zr + (size_t)m * DR + zc)); f32x4 prv = z4; if (mp >= sb && mp < se) prv = ld4bf((const bf16*)(Zr + (size_t)mp * DR + zc));
                const f32x4 mu4 = *(const f32x4*)(ka->in[I_MU] + d * DR + zc); f32x4 zs = cur + mu4 * (prv - cur);
                if (col < 64) {
#pragma unroll
                    for (int q = 0; q < 4; ++q) zs[q] = 1.f - 2.f * __builtin_amdgcn_rcpf(1.f + __expf(2.f * zs[q]));
                    *(LAS v2u*)(Aw + tok * 72 + col) = __builtin_bit_cast(v2u, pk4(zs)); }
                else if (col < 128) *(LAS v2u*)(Aa + tok * 72 + col - 64) = __builtin_bit_cast(v2u, pk4(zs));
                else {
#pragma unroll
                    for (int q = 0; q < 4; ++q) zs[q] = __builtin_amdgcn_rcpf(1.f + __expf(-zs[q]));
                    *(LAS v2u*)(Ag + tok * 136 + col - 128) = __builtin_bit_cast(v2u, pk4(zs)); } }
        }
        __syncthreads();
#pragma unroll 1
        for (int sg = 0; sg < SPG; ++sg) { const int s4 = grp * SPG + sg;
            int ln = LANEID_FRESH(); asm volatile("" : "+v"(ln));
            const int n = ln & 15, g = ln >> 4, chl = h * 64 + 4 * n;
            bf16x4 idB;
#pragma unroll
            for (int j = 0; j < 4; ++j) idB[j] = (4 * g + j == n) ? (short)0x3F80 : (short)0;
            const int jj0 = 16 * s4 + 4 * g;
            const f32x4 mur = *(const f32x4*)(ka->in[I_MU] + d * DR + chl), muk = *(const f32x4*)(ka->in[I_MU] + d * DR + 512 + chl), muv = *(const f32x4*)(ka->in[I_MU] + d * DR + 1024 + chl);
            const f32x4 kkp = *(const f32x4*)(ka->in[I_KK] + d * DH + chl), kap = *(const f32x4*)(ka->in[I_KA] + d * DH + chl);
            f32x4 rkp = z4; if (!PA) rkp = *(const f32x4*)(ka->in[I_RK] + d * DH + chl);
            const f32x4 w0p = *(const f32x4*)(ka->in[I_W0] + d * DH + chl), a0p = *(const f32x4*)(ka->in[I_A0] + d * DH + chl);
            const int m0 = d ? row0 + 255 - jj0 : row0 + jj0;
            const bf16* wbase = WupT + ((size_t)((d * 8 + h) * 8) * 64 + ln) * 8; const bf16* abase = AupT + ((size_t)((d * 8 + h) * 8) * 64 + ln) * 8;
            f32x4 accw[4], acca[4];
#pragma unroll
            for (int c = 0; c < 4; ++c) { accw[c] = z4; acca[c] = z4; }
#pragma unroll
            for (int ks = 0; ks < 2; ++ks) { const bf16x8 aw = *(const LAS bf16x8*)(Aw + (16 * sg + n) * 72 + 32 * ks + 8 * g), aa = *(const LAS bf16x8*)(Aa + (16 * sg + n) * 72 + 32 * ks + 8 * g);
#pragma unroll
                for (int c = 0; c < 4; ++c) { const int wo = (c * 2 + ks) * 512;
                    accw[c] = MFMA32(aw, *(const bf16x8*)(wbase + wo), accw[c]); acca[c] = MFMA32(aa, *(const bf16x8*)(abase + wo), acca[c]); } }
            v2u zr[5], zk[5], zv[5];
#define UZ(w, c) __builtin_bit_cast(float, ((c) & 1) ? (((c) & 2) ? (w).y : (w).x) & 0xffff0000u : (((c) & 2) ? (w).y : (w).x) << 16)
#pragma unroll
            for (int q = 0; q < 5; ++q) { const int mq = m0 + (q - 1) * stp; const bool ok = (q > 0) || (mq >= sb && mq < se);
                zr[q] = (v2u){0u, 0u}; zk[q] = zr[q]; zv[q] = zr[q];
                if (ok) { gbf16p zp = Zr + (size_t)mq * DR + chl; typedef const __attribute__((address_space(1))) v2u* gv2; zr[q] = *(gv2)zp; zk[q] = *(gv2)(zp + 512); zv[q] = *(gv2)(zp + 1024); } }
            __builtin_amdgcn_sched_barrier(0);
            float ss[4] = {0.f, 0.f, 0.f, 0.f};
#pragma unroll
            for (int c = 0; c < 4; ++c)
#pragma unroll
                for (int i = 0; i < 4; ++i) { const float kq = (UZ(zk[i + 1], c) + muk[c] * (UZ(zk[i], c) - UZ(zk[i + 1], c))) * kkp[c]; ss[i] += kq * kq; }
#pragma unroll
            for (int i = 0; i < 4; ++i) ss[i] = rsqrtf(fmaxf(sum16(ss[i]), 1e-24f));
            bf16x4 Atc[4], Btc[4], Ktc[4], Vc[4], Rtc[4];
            float rk[4] = {0.f, 0.f, 0.f, 0.f}, cle[4];
#pragma unroll
            for (int c = 0; c < 4; ++c) { f32x4 At, Bt, Kt, Vv, Rt; float lw[4], E[5];
#pragma unroll
                for (int i = 0; i < 4; ++i) lw[i] = -0.60653066f * __builtin_amdgcn_rcpf(1.f + __expf(-(accw[c][i] + w0p[c])));
                {
                    const float p0 = lw[0], p1 = p0 + lw[1], p2 = p1 + lw[2], p3 = p2 + lw[3];
                    const float t1 = BPERM(ln - 16, p3); float inc = p3 + (g >= 1 ? t1 : 0.f); const float t2 = BPERM(ln - 32, inc); inc += (g >= 2 ? t2 : 0.f);
                    const float ex = inc - p3; cle[c] = BPERM(48 + n, inc);
                    E[0] = __expf(ex); E[1] = __expf(ex + p0); E[2] = __expf(ex + p1); E[3] = __expf(ex + p2); E[4] = __expf(inc); }
#pragma unroll
                for (int i = 0; i < 4; ++i) {
                    const float kx = UZ(zk[i + 1], c) + muk[c] * (UZ(zk[i], c) - UZ(zk[i + 1], c));
                    const float av = __builtin_amdgcn_rcpf(1.f + __expf(-(acca[c][i] + a0p[c])));
                    const float kn = kx * kkp[c] * ss[i], km = kx * (1.f + (av - 1.f) * kap[c]), b = kn * av;
                    const float einv = __builtin_amdgcn_rcpf(E[i + 1]);
                    At[i] = -kn * E[i]; Bt[i] = b * einv; Kt[i] = km * einv;
                    Vv[i] = UZ(zv[i + 1], c) + muv[c] * (UZ(zv[i], c) - UZ(zv[i + 1], c));
                    if (!PA) { const float r = UZ(zr[i + 1], c) + mur[c] * (UZ(zr[i], c) - UZ(zr[i + 1], c)); Rt[i] = r * E[i + 1]; rk[i] += r * km * rkp[c]; } }
                Atc[c] = pk4(At); Btc[c] = pk4(Bt); Ktc[c] = pk4(Kt); Vc[c] = pk4(Vv); if (!PA) Rtc[c] = pk4(Rt);
                }
            bf16x8 AtT[2], BtT[2], KtT[2], RtT[2];
#pragma unroll
            for (int ks = 0; ks < 2; ++ks) {
                AtT[ks] = pk8(MFMA16(Atc[2 * ks], idB, z4), MFMA16(Atc[2 * ks + 1], idB, z4));
                BtT[ks] = pk8(MFMA16(Btc[2 * ks], idB, z4), MFMA16(Btc[2 * ks + 1], idB, z4));
                KtT[ks] = pk8(MFMA16(Ktc[2 * ks], idB, z4), MFMA16(Ktc[2 * ks + 1], idB, z4));
                if (!PA) RtT[ks] = pk8(MFMA16(Rtc[2 * ks], idB, z4), MFMA16(Rtc[2 * ks + 1], idB, z4)); }
            f32x4 Nn = MFMA32(AtT[1], BtT[1], MFMA32(AtT[0], BtT[0], z4));
            f32x4 NT = MFMA32(BtT[1], AtT[1], MFMA32(BtT[0], AtT[0], z4));
            f32x4 Akt = MFMA32(KtT[1], AtT[1], MFMA32(KtT[0], AtT[0], z4));
#pragma unroll
            for (int i = 0; i < 4; ++i) { const int rr = 4 * g + i; if (!(n < rr)) Nn[i] = 0.f; if (!(rr < n)) { NT[i] = 0.f; Akt[i] = 0.f; } }
            bf16x4 pRB, pRK;
            if (!PA) { f32x4 Arbt = MFMA32(BtT[1], RtT[1], MFMA32(BtT[0], RtT[0], z4)), Arkt = MFMA32(KtT[1], RtT[1], MFMA32(KtT[0], RtT[0], z4));
#pragma unroll
                for (int i = 0; i < 4; ++i) if (!(4 * g + i <= n)) { Arbt[i] = 0.f; Arkt[i] = 0.f; }
                pRB = pk4(Arbt); pRK = pk4(Arkt); }
            const bf16x4 pN = pk4(Nn), pNT = pk4(NT), pAk = pk4(Akt);
            const f32x4 N2 = MFMA16(pNT, pN, z4), NT2 = MFMA16(pN, pNT, z4);
            const bf16x4 pN2 = pk4(N2), pNT2 = pk4(NT2);
            const f32x4 N4 = MFMA16(pNT2, pN2, z4), NT4 = MFMA16(pN2, pNT2, z4);
            const bf16x4 pN4 = pk4(N4), pNT4 = pk4(NT4);
            const bf16x4 pNT8 = pk4(MFMA16(pN4, pNT4, z4));
            __builtin_amdgcn_sched_barrier(0);
            f32x4 Y[4];
            {
                constexpr int hv = PP ? 1 : 0;
                f32x4 X[4];
#pragma unroll
                for (int v = 0; v < 4; ++v) { const int vc = v;
                    const bf16x8 Hb0 = pk8(H[0][vc], H[1][vc]), Hb1 = pk8(H[2][vc], H[3][vc]);
                    X[v] = MFMA32(AtT[1], Hb1, MFMA32(AtT[0], Hb0, z4));
                    if (hv == 0) X[v] = MFMA16(pAk, Vc[v], X[v]);
                    if (!PA) Y[v] = MFMA32(RtT[1], Hb1, MFMA32(RtT[0], Hb0, z4)); }
#pragma unroll
                for (int v = 0; v < 4; ++v) X[v] = MFMA16(pNT8, pk4(X[v]), X[v]);
#pragma unroll
                for (int v = 0; v < 4; ++v) X[v] = MFMA16(pNT4, pk4(X[v]), X[v]);
#pragma unroll
                for (int v = 0; v < 4; ++v) X[v] = MFMA16(pNT2, pk4(X[v]), X[v]);
#pragma unroll
                for (int v = 0; v < 4; ++v) X[v] = MFMA16(pNT, pk4(X[v]), X[v]);
                f32x4 g15[4];
#pragma unroll
                for (int c = 0; c < 4; ++c) g15[c] = __builtin_amdgcn_mfma_f32_16x16x4f32(g == 0 ? __expf(cle[c]) : 0.f, 1.f, z4, 0, 0, 0);
#pragma unroll
                for (int v = 0; v < 4; ++v) { const int vc = v; const bf16x4 pU = pk4(X[v]);
                    if (hv == 0) { const bf16x8 UV = cat8(pU, Vc[v]);
                        if (!PA) Y[v] = MFMA32(cat8(pRB, pRK), UV, Y[v]);
#pragma unroll
                        for (int kc = 0; kc < 4; ++kc) H[kc][vc] = MFMA32(cat8(Btc[kc], Ktc[kc]), UV, H[kc][vc]) * g15[kc]; }
                    else {
#pragma unroll
                        for (int kc = 0; kc < 4; ++kc) H[kc][vc] = MFMA16(Btc[kc], pU, H[kc][vc]) * g15[kc]; } }
                if (PA) {
#pragma unroll
                    for (int vp = 0; vp < 4; vp += 2) { f32x4 Hp[2][4], Xp[2];
#pragma unroll
                        for (int t = 0; t < 2; ++t)
#pragma unroll
                            for (int kc = 0; kc < 4; ++kc) Hp[t][kc] = *(const LAS f32x4*)(HP + ((kc * 4 + vp + t) * 64 + ln) * 4);
#pragma unroll
                        for (int t = 0; t < 2; ++t) Xp[t] = MFMA32(AtT[1], pk8(Hp[t][2], Hp[t][3]), MFMA32(AtT[0], pk8(Hp[t][0], Hp[t][1]), z4));
#pragma unroll
                        for (int t = 0; t < 2; ++t) Xp[t] = MFMA16(pNT8, pk4(Xp[t]), Xp[t]);
#pragma unroll
                        for (int t = 0; t < 2; ++t) Xp[t] = MFMA16(pNT4, pk4(Xp[t]), Xp[t]);
#pragma unroll
                        for (int t = 0; t < 2; ++t) Xp[t] = MFMA16(pNT2, pk4(Xp[t]), Xp[t]);
#pragma unroll
                        for (int t = 0; t < 2; ++t) Xp[t] = MFMA16(pNT, pk4(Xp[t]), Xp[t]);
#pragma unroll
                        for (int t = 0; t < 2; ++t) { const bf16x4 pU = pk4(Xp[t]);
#pragma unroll
                            for (int kc = 0; kc < 4; ++kc) *(LAS f32x4*)(HP + ((kc * 4 + vp + t) * 64 + ln) * 4) = MFMA16(Btc[kc], pU, Hp[t][kc]) * g15[kc]; } }
                }
            }
            __builtin_amdgcn_sched_barrier(0);
            if (!PA) {
                int le = LANEID_FRESH(); asm volatile("" : "+v"(le));
                const int ne = le & 15, ge = le >> 4, che = h * 64 + 4 * ne;
                {   const f32x4 lnw = *(const f32x4*)(ka->in[I_LNW] + d * DH + che), lnb = *(const f32x4*)(ka->in[I_LNB] + d * DH + che);
#pragma unroll
                    for (int i = 0; i < 4; ++i) { const float mean = sum16((Y[0][i] + Y[1][i]) + (Y[2][i] + Y[3][i])) * (1.f / 64.f);
                        float q = 0.f;
#pragma unroll
                        for (int v = 0; v < 4; ++v) { const float dv = Y[v][i] - mean; q += dv * dv; }
                        const float rs = rsqrtf(sum16(q) * (1.f / 64.f) + GN_EPS), rki = sum16(rk[i]);
#pragma unroll
                        for (int v = 0; v < 4; ++v) Y[v][i] = (Y[v][i] - mean) * rs * lnw[v] + lnb[v] + rki * bf2f((unsigned short)Vc[v][i]); } }
                __builtin_amdgcn_sched_barrier(0);
                f32x4 accg[4]; const bf16* gbase = GupT + ((size_t)((d * 8 + h) * 16) * 64 + le) * 8;
#pragma unroll
                for (int c = 0; c < 4; ++c) accg[c] = z4;
#pragma unroll
                for (int ks = 0; ks < 4; ++ks) { const bf16x8 ag = *(const LAS bf16x8*)(Ag + (16 * sg + ne) * 136 + 32 * ks + 8 * ge);
#pragma unroll
                    for (int c = 0; c < 4; ++c) accg[c] = MFMA32(ag, *(const bf16x8*)(gbase + (c * 4 + ks) * 512), accg[c]); }
#pragma unroll
                for (int i = 0; i < 4; ++i) { f32x4 o;
#pragma unroll
                    for (int v = 0; v < 4; ++v) o[v] = Y[v][i] * accg[v][i];
                    *(v2u*)(YC + (size_t)((d ? row0 + 255 - 16 * s4 - 4 * ge : row0 + 16 * s4 + 4 * ge) + i * stp) * YP + 512 + d * 512 + che) = __builtin_bit_cast(v2u, pk4(o)); }
            }
        }
        __syncthreads();
    }
    if (PA) {
#pragma unroll
        for (int kc = 0; kc < 4; ++kc) {
#pragma unroll
            for (int vc = 0; vc < 4; ++vc) *(v2u*)(QB + unit + ((kc * 4 + vc) * 64 + lane) * 4) = __builtin_bit_cast(v2u, pk4(H[kc][vc]));
#pragma unroll
            for (int ks = 0; ks < 2; ++ks) { f32x4 e0, e1;
#pragma unroll
                for (int jj = 0; jj < 4; ++jj) { const int src = 16 * (n >> 2) + 4 * g + jj;
                    e0[jj] = HP[((kc * 4 + 2 * ks) * 64 + src) * 4 + (n & 3)]; e1[jj] = HP[((kc * 4 + 2 * ks + 1) * 64 + src) * 4 + (n & 3)]; }
                *(bf16x8*)(PBH + unit + ((kc * 2 + ks) * 64 + lane) * 8) = pk8(e0, e1); } }
    }
}
constexpr int REPT = 1, REP0 = 1, REP3 = 1, REP4 = 1, REP5 = 1, REPG = 1, REP1 = 1, REPC = 1, REP7 = 1, REP12 = 1;
__global__ void __launch_bounds__(NTHR, 2) fwd(Args args) {
    extern __shared__ __attribute__((aligned(16))) unsigned char lds_raw[];
    LAS unsigned char* lds = (LAS unsigned char*)lds_raw;
    int bar_epoch = 0;
    const int wave_s = __builtin_amdgcn_readfirstlane(threadIdx.x >> 6);
    const int G = gridDim.x, bx = blockIdx.x;
    const int vcu = (G % 8 == 0) ? (bx % 8) * (G / 8) + bx / 8 : bx;
    const int NGW = G * NWAVES;
#define MKTID() (wave_s * 64 + LANEID_FRESH())
#define PHASE_IDS int tid = MKTID(); asm volatile("" : "+v"(tid)); const int lane = tid & 63, wave = __builtin_amdgcn_readfirstlane(tid >> 6), gw = vcu * NWAVES + wave; (void)gw; (void)lane;
#define PHASE_PTRS KArgs ka = (KArgs)__builtin_amdgcn_kernarg_segment_ptr(); asm volatile("" : "+s"(ka)); unsigned char* ws = ka->ws; unsigned char* dob = (unsigned char*)ka->out; \
    const float* xp = ka->in[I_XP]; const float* xs = ka->in[I_XS]; \
    float* MOD = (float*)(ws + WS_MOD); \
    bf16* WupT = (bf16*)(ws + WS_WUP); bf16* AupT = (bf16*)(ws + WS_AUP); bf16* GupT = (bf16*)(ws + WS_GUP); \
    bf16* HSB = (bf16*)(ws + WS_HS); bf16* PBH = (bf16*)(dob + DO_PB); bf16* QB = (bf16*)(dob + DO_QB); \
    bf16* WinT = (bf16*)(ws + WS_WIN); bf16* WoT = (bf16*)(ws + WS_WO); bf16* W1T = (bf16*)(ws + WS_W1); bf16* W2T = (bf16*)(ws + WS_W2); \
    bf16* Zr = (bf16*)(ws + WS_ZR); bf16* Zc = (bf16*)(ws + WS_ZC); \
    bf16* MIX = (bf16*)(ws + WS_MIX); bf16* XN2 = (bf16*)(ws + WS_XN2); bf16* FB = (bf16*)(ws + WS_F); \
    bf16* XN = (bf16*)(dob + DO_XN); bf16* YCAT = (bf16*)(dob + DO_YCAT); bf16* AHID = (bf16*)(dob + DO_AHID);
    const int lo = args.ph_lo, hi = args.ph_hi;
#define IN(k) (lo <= (k) && (k) < hi)
#define SEAM(k) do { if (IN(k) && IN((k) + 1)) { if ((k) == 0) cg::this_grid().sync(); else { \
        asm volatile("s_waitcnt vmcnt(0)" ::: "memory"); __syncthreads(); \
        if (MKTID() == 0) { unsigned* bw_ = (unsigned*)((KArgs)__builtin_amdgcn_kernarg_segment_ptr())->ws + WS_BAR / 4; \
            __builtin_amdgcn_fence(__ATOMIC_RELEASE, "agent"); asm volatile("s_waitcnt vmcnt(0)" ::: "memory"); \
            const unsigned e_ = (unsigned)(++bar_epoch), ng_ = (G % 8 == 0) ? 8u : 1u;                      \
            const unsigned old_ = __hip_atomic_fetch_add(bw_ + 64 * (ng_ == 8u ? (bx & 7) : 0), 1u, __ATOMIC_RELAXED, __HIP_MEMORY_SCOPE_AGENT); \
            if (old_ + 1u == e_ * ((unsigned)G / ng_)) { const unsigned t_ = __hip_atomic_fetch_add(bw_ + 64 * 8, 1u, __ATOMIC_RELAXED, __HIP_MEMORY_SCOPE_AGENT); \
                if (t_ + 1u == e_ * ng_) { for (unsigned q_ = 0; q_ < 8; ++q_) __hip_atomic_store(bw_ + 64 * (16 + q_), e_, __ATOMIC_RELAXED, __HIP_MEMORY_SCOPE_AGENT); } }     \
            unsigned* rel_ = bw_ + 64 * (16 + (ng_ == 8u ? (bx & 7) : 0)); unsigned sp_ = 0; \
            while (__hip_atomic_load(rel_, __ATOMIC_RELAXED, __HIP_MEMORY_SCOPE_AGENT) < e_ && ++sp_ < (1u << 24)) __builtin_amdgcn_s_sleep(1); \
            __builtin_amdgcn_fence(__ATOMIC_ACQUIRE, "agent"); asm volatile("s_waitcnt vmcnt(0)" ::: "memory"); } \
        __syncthreads(); } } } while (0)
#define XROW(m) ((m) < 16384 ? xp + (size_t)(m) * DM : xs + (size_t)((m) - 16384) * DM)

    for (int rep0 = 0; rep0 < REP0; ++rep0)
    if (IN(0)) { PHASE_PTRS PHASE_IDS
        if (bx == 0 && tid < 64) { for (int i = tid; i < 128; i += 64) __hip_atomic_store((unsigned*)(ws + WS_BAR) + 64 * i, 0u, __ATOMIC_RELAXED, __HIP_MEMORY_SCOPE_AGENT); }
        if (bx < 96) {
            LAS float* sc = (LAS float*)lds;
            for (int i = tid; i < 3072; i += NTHR) { const int s = i >> 10, k = i & 1023; const float c = (s < 2) ? ka->in[I_CP][s * 1024 + k] : ka->in[I_CS][k]; sc[i] = c / (1.f + __expf(-c)); }
            __syncthreads();
            const int col = bx * 64 + lane, k0 = wave * 128; const float* wa = ka->in[I_WADA];
            float a0 = 0.f, a1 = 0.f, a2 = 0.f;
#pragma unroll 32
            for (int k = k0; k < k0 + 128; ++k) { const float w = __builtin_nontemporal_load(wa + (size_t)k * 6144 + col); a0 += sc[k] * w; a1 += sc[1024 + k] * w; a2 += sc[2048 + k] * w; }
            LAS float* red = sc + 3072;
            red[(wave * 3 + 0) * 64 + lane] = a0; red[(wave * 3 + 1) * 64 + lane] = a1; red[(wave * 3 + 2) * 64 + lane] = a2;
            __syncthreads();
            if (tid < 192) { const int s = tid >> 6, l = tid & 63; float v = ka->in[I_BADA][bx * 64 + l];
#pragma unroll
                for (int w = 0; w < 8; ++w) v += red[(w * 3 + s) * 64 + l];
                MOD[s * 6144 + bx * 64 + l] = v; }
            __syncthreads();
        }
        LAS float* scr = (LAS float*)(lds + wave * 16384);
        constexpr int I_IN = 16 * (DIN / 32), I_O = 16 * 32, I_L = 16, I_G = 32;
        constexpr int NIT = I_IN + I_O;
        for (int it = gw; it < NIT; it += NGW) {
            int r = it;
            if (r < I_IN) { transpose_item(ka->in[I_WIN], DM, DIN, WinT, scr, r, lane, 0, 0, true); continue; } r -= I_IN;
            if (r < I_O) { transpose_item(ka->in[I_WOUT], DM, DM, WoT, scr, r, lane, YP, 0); if (r >= I_O / 2) transpose_item(ka->in[I_WOUT], DM, DM, WoT, scr, r, lane, YP, 512); continue; } r -= I_O;
            continue;
        }
        for (int q = gw * 64 + lane; q < 32768; q += NGW * 64) {
            const float* W; bf16* F; int KS, qq = q;
            if (qq < 8192) { W = ka->in[I_WUP]; F = WupT; KS = 2; } else if (qq < 16384) { qq -= 8192; W = ka->in[I_AUP]; F = AupT; KS = 2; } else { qq -= 16384; W = ka->in[I_GUP]; F = GupT; KS = 4; }
            const int ln = qq & 63, ks = (qq >> 6) % KS, rest = (qq >> 6) / KS, c = rest & 3, h = (rest >> 2) & 7, d = rest >> 5, n = ln & 15, g = ln >> 4;
            const float* src = W + ((size_t)d * (32 * KS) + 32 * ks + 8 * g) * DH + 64 * h + 4 * n + c;
            v4u o; o.x = pk2(src[0], src[DH]); o.y = pk2(src[2 * DH], src[3 * DH]); o.z = pk2(src[4 * DH], src[5 * DH]); o.w = pk2(src[6 * DH], src[7 * DH]);
            *(v4u*)(F + (size_t)qq * 8) = o;
        }
    }
    SEAM(0);

    if (IN(1)) { PHASE_PTRS PHASE_IDS
        for (int rep = 0; rep < REP1; ++rep)
        for (int rg = gw; rg < MTOK / 16; rg += NGW) {
            const int m0 = rg * 16; const float* modS = MOD + seq_id(m0) * 6144;
            f32x4 A[4], B[4];
#pragma unroll
            for (int j = 0; j < 4; ++j) { const int c = 4 * lane + 256 * j; const f32x4 g = *(const f32x4*)(ka->in[I_GPRE] + c), scv = *(const f32x4*)(modS + 1024 + c); A[j] = g * (1.f + scv); B[j] = *(const f32x4*)(modS + c); }
            for (int r = 0; r < 16; ++r) { const int m = m0 + r; const f32x4* xr = (const f32x4*)XROW(m) + lane;
                f32x4 v[4]; float ss = 0.f;
#pragma unroll
                for (int j = 0; j < 4; ++j) { v[j] = __builtin_nontemporal_load(xr + 64 * j); ss += (v[j].x * v[j].x + v[j].y * v[j].y) + (v[j].z * v[j].z + v[j].w * v[j].w); }
                const float rstd = rsqrtf(wave_sum(ss) * (1.f / DM) + NORM_EPS);
                v2u* o = (v2u*)(XN + (size_t)m * DM) + lane;
#pragma unroll
                for (int j = 0; j < 4; ++j) { const f32x4 h = v[j] * rstd * A[j] + B[j]; v2u w; w.x = pk2(h.x, h.y); w.y = pk2(h.z, h.w); o[64 * j] = w; }
            }
        }
    }
    SEAM(1);

    if (IN(2)) { PHASE_PTRS
        pg8::Gemm g{XN, WinT, MTOK, DIN, DM}; pg8::StaticOrder S; S.init(MTOK, DIN, G, bx);
        pg8::EpiB E{Zc, ZCP, 6, Zr, DR, 0, nullptr, 0u, 2};
        for (int rep = 0; rep < REPG; ++rep) pg8::gemm_phase<pg8::EpiB, pg8::StaticOrder, true, true>(lds, g, S, E, MKTID());
    }
    SEAM(2);

    if (IN(3)) { PHASE_PTRS
        for (int rep = 0; rep < REP3; ++rep)
        for (int u = bx; u < 256; u += G) scan_unit<1>(ka, lds, Zr, WupT, AupT, GupT, u >> 7, u & 127, PBH, QB, nullptr, nullptr, wave_s);
    }
    SEAM(3);

    if (IN(4)) { PHASE_PTRS PHASE_IDS
        for (int rep = 0; rep < REP4; ++rep)
        if (bx < 192 && wave == 0) {
            const int vc = bx & 3, h = (bx >> 2) & 7, ds = bx >> 5, d = ds & 1, s = ds >> 1;
            const int wb = (s == 0) ? 0 : (s == 1 ? 32 : 64), nwin = (s < 2) ? 32 : 64, nst = nwin - 1;
            f32x4 Hc[4]; bf16x8 Pr[3][4][2]; f32x4 Qr[3][4];
#pragma unroll
            for (int kc = 0; kc < 4; ++kc) Hc[kc] = (f32x4){0.f, 0.f, 0.f, 0.f};
#define PB_UNIT(w) ((size_t)((d * 128 + (d ? wb + nwin - 1 - (w) : wb + (w))) * 8 + h) * 4096)
#define PB_LOAD(slot, w) do { const size_t un_ = PB_UNIT(w); _Pragma("unroll") for (int kc = 0; kc < 4; ++kc) { Qr[slot][kc] = ld4bf(QB + un_ + ((kc * 4 + vc) * 64 + lane) * 4); \
        _Pragma("unroll") for (int ks = 0; ks < 2; ++ks) Pr[slot][kc][ks] = *(const bf16x8*)(PBH + un_ + ((kc * 2 + ks) * 64 + lane) * 8); } } while (0)
#define PB_STEP(slot, w) do { const size_t un_ = PB_UNIT(w); \
        _Pragma("unroll") for (int kc = 0; kc < 4; ++kc) *(v2u*)(HSB + un_ + ((kc * 4 + vc) * 64 + lane) * 4) = __builtin_bit_cast(v2u, pk4(Hc[kc])); \
        bf16x8 Hh[2], Hl[2]; \
        _Pragma("unroll") for (int ks = 0; ks < 2; ++ks) { Hh[ks] = pk8(Hc[2 * ks], Hc[2 * ks + 1]); f32x4 r0, r1; \
            _Pragma("unroll") for (int i = 0; i < 4; ++i) { r0[i] = Hc[2 * ks][i] - bf2f((unsigned short)Hh[ks][i]); r1[i] = Hc[2 * ks + 1][i] - bf2f((unsigned short)Hh[ks][4 + i]); } \
            Hl[ks] = pk8(r0, r1); } \
        _Pragma("unroll") for (int kc = 0; kc < 4; ++kc) { f32x4 acc = Qr[slot][kc]; \
            _Pragma("unroll") for (int ks = 0; ks < 2; ++ks) { acc = MFMA32(Pr[slot][kc][ks], Hh[ks], acc); acc = MFMA32(Pr[slot][kc][ks], Hl[ks], acc); } \
            Hc[kc] = acc; } \
        if ((w) + 3 < nst) PB_LOAD(slot, (w) + 3); } while (0)
            PB_LOAD(0, 0); PB_LOAD(1, 1); PB_LOAD(2, 2);
#pragma unroll 1
            for (int w = 0; w < nst; w += 3) {
                PB_STEP(0, w);
                if (w + 1 < nst) PB_STEP(1, w + 1);
                if (w + 2 < nst) PB_STEP(2, w + 2);
            }
            { const size_t un_ = PB_UNIT(nst);
#pragma unroll
              for (int kc = 0; kc < 4; ++kc) *(v2u*)(HSB + un_ + ((kc * 4 + vc) * 64 + lane) * 4) = __builtin_bit_cast(v2u, pk4(Hc[kc])); }
#undef PB_UNIT
#undef PB_LOAD
#undef PB_STEP
        }
    }
    SEAM(4);

    if (IN(5)) { PHASE_PTRS
        for (int rep = 0; rep < REP5; ++rep)
        for (int u = bx; u < 256; u += G) scan_unit<0>(ka, lds, Zr, WupT, AupT, GupT, u >> 7, u & 127, nullptr, nullptr, HSB, YCAT, wave_s);
        PHASE_IDS
        for (int rep = 0; rep < REPC; ++rep)
        for (int rg = vcu * 4 + (tid >> 7); rg < MTOK / 16; rg += G * 4) {
            const int m0 = rg * 16, sb = seq_beg(m0), se = seq_end(m0), c = 4 * (tid & 127);
            const float* cw = ka->in[I_CONVW]; const f32x4 cw0 = *(const f32x4*)(cw + c), cw1 = *(const f32x4*)(cw + 512 + c), cw2 = *(const f32x4*)(cw + 1024 + c);
            f32x4 p = {0.f, 0.f, 0.f, 0.f}, q;
            if (m0 - 1 >= sb) p = ld4bf_nt(Zc + (size_t)(m0 - 1) * ZCP + 512 + c);
            q = ld4bf_nt(Zc + (size_t)m0 * ZCP + 512 + c);
#pragma unroll 4
            for (int i = 0; i < 16; ++i) { const int m = m0 + i; f32x4 nx = {0.f, 0.f, 0.f, 0.f};
                if (m + 1 < se) nx = ld4bf_nt(Zc + (size_t)(m + 1) * ZCP + 512 + c);
                const f32x4 y = ld4bf_nt(Zc + (size_t)m * ZCP + c) * (cw0 * p + cw1 * q + cw2 * nx);
                v2u w; w.x = pk2(y.x, y.y); w.y = pk2(y.z, y.w); *(v2u*)(YCAT + (size_t)m * YP + c) = w; p = q; q = nx; }
        }
    }
    SEAM(5);

    if (IN(6)) { PHASE_PTRS
        pg8::Gemm g{YCAT, WoT, MTOK, DM, YP}; pg8::StaticOrder S; S.init(MTOK, DM, G, bx);
        pg8::EpiB E{MIX, DM, 1 << 20, nullptr, 0, 0};
        for (int rep = 0; rep < REPG; ++rep) pg8::gemm_phase<pg8::EpiB, pg8::StaticOrder, true, true>(lds, g, S, E, MKTID());
    }
    SEAM(6);

    if (IN(7)) { PHASE_PTRS PHASE_IDS
        LAS float* scr = (LAS float*)(lds + wave * 16384);
        constexpr int I_1 = 16 * (DFF / 32), I_2 = (DFF / 64) * 32;
        for (int rept = 0; rept < REPT; ++rept)
        for (int it = gw; it < I_1 + I_2; it += NGW) {
            if (it < I_1) transpose_item(ka->in[I_W1], DM, DFF, W1T, scr, it, lane); else transpose_item(ka->in[I_W2], DFF, DM, W2T, scr, it - I_1, lane);
        }
        for (int rep = 0; rep < REP7; ++rep)
        for (int rg = gw; rg < MTOK / 16; rg += NGW) {
            const int m0 = rg * 16; const float* modS = MOD + seq_id(m0) * 6144;
            f32x4 G1[4], A2[4], B2[4];
#pragma unroll
            for (int j = 0; j < 4; ++j) { const int c = 4 * lane + 256 * j;
                G1[j] = *(const f32x4*)(modS + 2048 + c) * *(const f32x4*)(ka->in[I_GPOST] + c);
                A2[j] = *(const f32x4*)(ka->in[I_GPRE2] + c) * (1.f + *(const f32x4*)(modS + 4096 + c)); B2[j] = *(const f32x4*)(modS + 3072 + c); }
            for (int r = 0; r < 16; ++r) { const int m = m0 + r; const f32x4* xr = (const f32x4*)XROW(m) + lane;
                f32x4 x[4], mx[4]; float ss = 0.f;
#pragma unroll
                for (int j = 0; j < 4; ++j) { x[j] = __builtin_nontemporal_load(xr + 64 * j); mx[j] = ld4bf_nt(MIX + (size_t)m * DM + 4 * lane + 256 * j); ss += (mx[j].x * mx[j].x + mx[j].y * mx[j].y) + (mx[j].z * mx[j].z + mx[j].w * mx[j].w); }
                const float rs1 = rsqrtf(wave_sum(ss) * (1.f / DM) + NORM_EPS); float s2 = 0.f;
#pragma unroll
                for (int j = 0; j < 4; ++j) { x[j] = x[j] + G1[j] * mx[j] * rs1; s2 += (x[j].x * x[j].x + x[j].y * x[j].y) + (x[j].z * x[j].z + x[j].w * x[j].w); }
                const float rs2 = rsqrtf(wave_sum(s2) * (1.f / DM) + NORM_EPS);
                v2u* o = (v2u*)(XN2 + (size_t)m * DM) + lane; v2u* o1 = (v2u*)(MIX + (size_t)m * DM) + lane;
#pragma unroll
                for (int j = 0; j < 4; ++j) { const f32x4 hh = x[j] * rs2 * A2[j] + B2[j]; v2u w; w.x = pk2(hh.x, hh.y); w.y = pk2(hh.z, hh.w); o[64 * j] = w;
                    v2u w1; w1.x = pk2(x[j].x, x[j].y); w1.y = pk2(x[j].z, x[j].w); __builtin_nontemporal_store(w1, o1 + 64 * j); }
            }
        }
    }
    SEAM(7);

#pragma unroll 1
    for (int half = 0; half < 2; ++half) {
        if (IN(8 + 2 * half)) { PHASE_PTRS
            pg8::Gemm g{XN2 + (size_t)half * 16384 * DM, W1T, 16384, DFF, DM}; pg8::StaticOrder S; S.init(16384, DFF, G, bx);
            pg8::EpiB E{AHID, DFF, 1 << 20, nullptr, 0, 1, (unsigned*)(ws + WS_BAR) + 64 * 32, (unsigned)(16384u * DFF * 2u)};
            for (int rep = 0; rep < REPG; ++rep) pg8::gemm_phase<pg8::EpiB, pg8::StaticOrder, true, true>(lds, g, S, E, MKTID());
        }
        if (IN(9 + 2 * half)) { PHASE_PTRS
            pg8::Gemm g{AHID, W2T, 16384, DM, DFF}; pg8::CountedOrder S; S.init(16384, DM, G, bx);
            S.ready = (const unsigned*)(ws + WS_BAR) + 64 * 32; S.need = 128u * (unsigned)(half + 1); S.is_wave0 = (wave_s == 0);
            pg8::EpiB E{FB + (size_t)half * 16384 * DM, DM, 1 << 20, nullptr, 0, 0, nullptr, 0u, 0, 1};
            for (int rep = 0; rep < REPG; ++rep) pg8::gemm_phase<pg8::EpiB, pg8::CountedOrder, false, true>(lds, g, S, E, MKTID());
        }
        SEAM(9 + 2 * half);
    }

    if (IN(12)) { PHASE_PTRS PHASE_IDS
        for (int rep = 0; rep < REP12; ++rep)
        for (int rg = gw; rg < MTOK / 16; rg += NGW) {
            const int m0 = rg * 16; const float* modS = MOD + seq_id(m0) * 6144;
            f32x4 G2[4];
#pragma unroll
            for (int j = 0; j < 4; ++j) { const int c = 4 * lane + 256 * j; G2[j] = *(const f32x4*)(modS + 5120 + c) * *(const f32x4*)(ka->in[I_GPOST2] + c); }
            for (int r = 0; r < 16; ++r) { const int m = m0 + r;
                f32x4 x1[4], fx[4]; float sf = 0.f;
#pragma unroll
                for (int j = 0; j < 4; ++j) { x1[j] = ld4bf_nt(MIX + (size_t)m * DM + 4 * lane + 256 * j); fx[j] = ld4bf_nt(FB + (size_t)m * DM + 4 * lane + 256 * j);
                    sf += (fx[j].x * fx[j].x + fx[j].y * fx[j].y) + (fx[j].z * fx[j].z + fx[j].w * fx[j].w); }
                const float rs3 = rsqrtf(wave_sum(sf) * (1.f / DM) + NORM_EPS);
                f32x4* o = (f32x4*)(ka->out + (size_t)m * DM) + lane;
#pragma unroll
                for (int j = 0; j < 4; ++j) __builtin_nontemporal_store(x1[j] + G2[j] * fx[j] * rs3, o + 64 * j);
            }
        }
    }
#undef IN
#undef SEAM
#undef XROW
}

constexpr int N_PHASES = 13;
extern "C" void kernel_launch(void* const* d_in, const int* in_sizes, int n_in, void* d_out, int out_size, void* d_ws, size_t ws_size, hipStream_t stream) {
    static int grid = 0;
    if (grid == 0) {
        if (n_in != 26 || out_size != MTOK * DM || ws_size < WS_NEED) { fprintf(stderr, "kernel_launch: unexpected shapes (n_in %d out %d ws %zu)\n", n_in, out_size, ws_size); grid = -1; return; }
        int dev = 0, cus = 0, per_cu = 0;
        hipGetDevice(&dev); hipDeviceGetAttribute(&cus, hipDeviceAttributeMultiprocessorCount, dev);
        if (hipFuncSetAttribute((const void*)fwd, hipFuncAttributeMaxDynamicSharedMemorySize, LDS_BYTES) != hipSuccess) { fprintf(stderr, "kernel_launch: hipFuncSetAttribute failed\n"); grid = -1; return; }
        if (hipOccupancyMaxActiveBlocksPerMultiprocessor(&per_cu, (const void*)fwd, NTHR, LDS_BYTES) != hipSuccess || per_cu < 1) { fprintf(stderr, "kernel_launch: occupancy query failed (%d)\n", per_cu); per_cu = 1; }
        (void)hipGetLastError();
        grid = cus * per_cu; if (grid > 256) grid = 256;
        fprintf(stderr, "kernel_launch: grid %d (cus %d per_cu %d)\n", grid, cus, per_cu);
    }
    if (grid < 0) return;
    Args a{};
    for (int i = 0; i < 26; ++i) a.in[i] = (const float*)d_in[i];
    a.out = (float*)d_out; a.ws = (unsigned char*)d_ws; a.ph_lo = 0; a.ph_hi = N_PHASES;
    void* kargs[] = {&a};
    hipError_t e = hipLaunchCooperativeKernel((const void*)fwd, dim3(grid), dim3(NTHR), kargs, LDS_BYTES, stream);
    if (e != hipSuccess) fprintf(stderr, "kernel_launch: cooperative launch failed: %s (grid %d)\n", hipGetErrorString(e), grid);
}
```
